# Optimizing an MI355X kernel written in HIP

```python
import math
import jax, jax.numpy as jnp
from jax import lax
import numpy as np

D_MODEL = 1024
BATCH = 2
SEQ = 16384
DEPTH = 2

N_A_LAYERS = DEPTH // 2
N_B_LAYERS = DEPTH - N_A_LAYERS
N_DENSE_FFN = (DEPTH + 1) // 2
N_MOE_FFN = DEPTH // 2

RET_HEADS = 4
RET_QK_DIM = D_MODEL // RET_HEADS
RET_V_DIM = 2 * D_MODEL // RET_HEADS
RET_CHUNK = 128

DIFF_HEADS = 8
DIFF_HEAD_DIM = D_MODEL // DIFF_HEADS // 2
DIFF_V_DIM = 2 * DIFF_HEAD_DIM
Q_BLOCK = 128

D_FF_DENSE = 2816
N_EXPERTS = 8
TOP_K = 2
D_FF_EXPERT = 3584

ROPE_THETA = 10000.0
NORM_EPS = 1e-6
SUBLN_EPS = 1e-5

kernel_name = "yoco_retention_diffattn_moe_trunk"


def rms_norm(x, g, eps=NORM_EPS):
    xf = x.astype(jnp.float32)
    y = (xf * lax.rsqrt(jnp.mean(xf * xf, axis=-1, keepdims=True) + eps)).astype(x.dtype)
    return y if g is None else y * g


def rope_tables(seq, dim, dtype):
    inv = 1.0 / (ROPE_THETA ** (jnp.arange(0, dim, 2, dtype=jnp.float32) / dim))
    ang = jnp.arange(seq, dtype=jnp.float32)[:, None] * inv[None, :]
    ang = jnp.concatenate([ang, ang], axis=-1)
    return jnp.cos(ang).astype(dtype), jnp.sin(ang).astype(dtype)


def apply_rope(x, cos, sin):
    x1, x2 = jnp.split(x, 2, axis=-1)
    return x * cos + jnp.concatenate([-x2, x1], axis=-1) * sin


def retention(h, w_in, w_out):
    B, S, D = h.shape
    H, dk, dv, C = RET_HEADS, RET_QK_DIM, RET_V_DIM, RET_CHUNK
    dt = h.dtype
    proj = h @ w_in
    q, k, v, g = jnp.split(proj, [D, 2 * D, 4 * D], axis=-1)
    q = q.reshape(B, S, H, dk).transpose(0, 2, 1, 3)
    k = k.reshape(B, S, H, dk).transpose(0, 2, 1, 3)
    v = v.reshape(B, S, H, dv).transpose(0, 2, 1, 3)
    cos, sin = rope_tables(S, dk, dt)
    q = apply_rope(q, cos, sin)
    k = apply_rope(k, cos, sin) * (dk ** -0.5)

    log_gamma = jnp.log1p(-jnp.exp2(-5.0 - jnp.arange(H, dtype=jnp.float32)))
    pos = jnp.arange(C, dtype=jnp.float32)
    rel = pos[:, None] - pos[None, :]
    intra_decay = jnp.where(rel >= 0, jnp.exp(log_gamma[:, None, None] * jnp.maximum(rel, 0.0)), 0.0).astype(dt)
    q_decay = jnp.exp(log_gamma[:, None] * (pos + 1.0)).astype(dt)
    k_decay = jnp.exp(log_gamma[:, None] * (C - 1.0 - pos)).astype(dt)
    chunk_decay = jnp.exp(log_gamma * C).astype(dt)

    N = S // C
    qc = q.reshape(B, H, N, C, dk)
    kc = k.reshape(B, H, N, C, dk)
    vc = v.reshape(B, H, N, C, dv)
    scores = jnp.einsum('bhncd,bhnkd->bhnck', qc, kc) * intra_decay[None, :, None]
    intra = jnp.einsum('bhnck,bhnke->bhnce', scores, vc)

    def step(state, xs):
        qi, ki, vi = xs
        inter_i = jnp.einsum('bhcd,bhde->bhce', qi, state) * q_decay[None, :, :, None]
        state = state * chunk_decay[None, :, None, None] + jnp.einsum(
            'bhcd,bhce->bhde', ki * k_decay[None, :, :, None], vi)
        return state, inter_i

    state0 = jnp.zeros((B, H, dk, dv), dt)
    _, inter = lax.scan(step, state0, (qc.transpose(2, 0, 1, 3, 4),
                                        kc.transpose(2, 0, 1, 3, 4),
                                        vc.transpose(2, 0, 1, 3, 4)))
    inter = inter.transpose(1, 2, 0, 3, 4)
    o = (intra + inter).reshape(B, H, S, dv).transpose(0, 2, 1, 3)
    o = rms_norm(o, None).reshape(B, S, H * dv)
    return (jax.nn.silu(g) * o) @ w_out


def shared_kv(x, kv_norm_g, w_kv):
    B, S, _ = x.shape
    H, d = DIFF_HEADS, DIFF_HEAD_DIM
    kv = rms_norm(x, kv_norm_g) @ w_kv
    k, v = jnp.split(kv, [H * 2 * d], axis=-1)
    k = k.reshape(B, S, H, 2, d).transpose(0, 2, 3, 1, 4)
    cos, sin = rope_tables(S, d, x.dtype)
    k = apply_rope(k, cos, sin)
    v = v.reshape(B, S, H, DIFF_V_DIM).transpose(0, 2, 1, 3)
    return k, v


def diff_attention(h, k, v, w_q, lam_q1, lam_k1, lam_q2, lam_k2, subln_g, w_o, lambda_init):
    B, S, _ = h.shape
    H, d, C = DIFF_HEADS, DIFF_HEAD_DIM, Q_BLOCK
    q = (h @ w_q).reshape(B, S, H, 2, d).transpose(0, 2, 3, 1, 4)
    cos, sin = rope_tables(S, d, h.dtype)
    q = apply_rope(q, cos, sin) * (d ** -0.5)
    lam = (jnp.exp(jnp.sum(lam_q1.astype(jnp.float32) * lam_k1.astype(jnp.float32)))
           - jnp.exp(jnp.sum(lam_q2.astype(jnp.float32) * lam_k2.astype(jnp.float32)))
           + lambda_init)
    nq = S // C
    qb = q.reshape(B, H, 2, nq, C, d).transpose(3, 0, 1, 2, 4, 5)
    key_pos = jnp.arange(S)
    neg = jnp.finfo(jnp.float32).min

    def block(args):
        qi, bi = args
        logits = jnp.einsum('bhpcd,bhpsd->bhpcs', qi, k).astype(jnp.float32)
        qpos = bi * C + jnp.arange(C)
        mask = key_pos[None, :] <= qpos[:, None]
        a = jax.nn.softmax(jnp.where(mask, logits, neg), axis=-1)
        attn = a[:, :, 0] - lam * a[:, :, 1]
        return jnp.einsum('bhcs,bhse->bhce', attn.astype(v.dtype), v)

    out = lax.map(block, (qb, jnp.arange(nq)))
    out = out.transpose(1, 0, 3, 2, 4).reshape(B, S, H, DIFF_V_DIM)
    out = rms_norm(out, subln_g, SUBLN_EPS) * (1.0 - lambda_init)
    return out.reshape(B, S, H * DIFF_V_DIM) @ w_o


def swiglu(h, w_gate, w_up, w_down):
    return (jax.nn.silu(h @ w_gate) * (h @ w_up)) @ w_down


def moe_swiglu(h, w_router, w_gate, w_up, w_down):
    B, S, D = h.shape
    t = h.reshape(B * S, D)
    logits = (t @ w_router).astype(jnp.float32)
    top_vals, top_idx = lax.top_k(logits, TOP_K)
    top_w = jax.nn.softmax(top_vals, axis=-1)
    gates = jnp.sum(jax.nn.one_hot(top_idx, N_EXPERTS, dtype=jnp.float32) * top_w[..., None], axis=1)
    gates = gates.astype(t.dtype)
    out = jnp.zeros_like(t)
    for e in range(N_EXPERTS):
        out = out + swiglu(t, w_gate[e], w_up[e], w_down[e]) * gates[:, e:e + 1]
    return out.reshape(B, S, D)


def setup_inputs(seed: int = 0) -> dict:
    key = jax.random.key(seed)
    ks = jax.random.split(key, 24)
    D, f32 = D_MODEL, jnp.float32

    def nrm(k, shape, fan_in, scale=1.0):
        return jax.random.normal(k, shape, f32) * (scale * fan_in ** -0.5)

    out_scale = (2.0 * DEPTH) ** -0.5
    return {
        "x": jax.random.normal(ks[0], (BATCH, SEQ, D), f32),
        "attn_norm_g": 1.0 + 0.02 * jax.random.normal(ks[1], (DEPTH, D), f32),
        "ffn_norm_g": 1.0 + 0.02 * jax.random.normal(ks[2], (DEPTH, D), f32),
        "ret_w_in": nrm(ks[3], (N_A_LAYERS, D, 6 * D), D),
        "ret_w_out": nrm(ks[4], (N_A_LAYERS, 2 * D, D), 2 * D, out_scale),
        "kv_norm_g": 1.0 + 0.02 * jax.random.normal(ks[5], (D,), f32),
        "w_kv": nrm(ks[6], (D, DIFF_HEADS * 2 * DIFF_HEAD_DIM + DIFF_HEADS * DIFF_V_DIM), D),
        "diff_w_q": nrm(ks[7], (N_B_LAYERS, D, DIFF_HEADS * 2 * DIFF_HEAD_DIM), D),
        "diff_lam_q1": 0.1 * jax.random.normal(ks[8], (N_B_LAYERS, DIFF_HEAD_DIM), f32),
        "diff_lam_k1": 0.1 * jax.random.normal(ks[9], (N_B_LAYERS, DIFF_HEAD_DIM), f32),
        "diff_lam_q2": 0.1 * jax.random.normal(ks[10], (N_B_LAYERS, DIFF_HEAD_DIM), f32),
        "diff_lam_k2": 0.1 * jax.random.normal(ks[11], (N_B_LAYERS, DIFF_HEAD_DIM), f32),
        "diff_subln_g": 1.0 + 0.02 * jax.random.normal(ks[12], (N_B_LAYERS, DIFF_V_DIM), f32),
        "diff_w_o": nrm(ks[13], (N_B_LAYERS, DIFF_HEADS * DIFF_V_DIM, D), DIFF_HEADS * DIFF_V_DIM, out_scale),
        "ffn_w_gate": nrm(ks[14], (N_DENSE_FFN, D, D_FF_DENSE), D),
        "ffn_w_up": nrm(ks[15], (N_DENSE_FFN, D, D_FF_DENSE), D),
        "ffn_w_down": nrm(ks[16], (N_DENSE_FFN, D_FF_DENSE, D), D_FF_DENSE, out_scale),
        "moe_w_router": nrm(ks[17], (N_MOE_FFN, D, N_EXPERTS), D),
        "moe_w_gate": nrm(ks[18], (N_MOE_FFN, N_EXPERTS, D, D_FF_EXPERT), D),
        "moe_w_up": nrm(ks[19], (N_MOE_FFN, N_EXPERTS, D, D_FF_EXPERT), D),
        "moe_w_down": nrm(ks[20], (N_MOE_FFN, N_EXPERTS, D_FF_EXPERT, D), D_FF_EXPERT, out_scale),
        "final_norm_g": 1.0 + 0.02 * jax.random.normal(ks[21], (D,), f32),
    }


def reference(x, attn_norm_g, ffn_norm_g, ret_w_in, ret_w_out, kv_norm_g, w_kv,
              diff_w_q, diff_lam_q1, diff_lam_k1, diff_lam_q2, diff_lam_k2, diff_subln_g, diff_w_o,
              ffn_w_gate, ffn_w_up, ffn_w_down,
              moe_w_router, moe_w_gate, moe_w_up, moe_w_down, final_norm_g):
    k_sh = None
    v_sh = None
    for i in range(DEPTH):
        h = rms_norm(x, attn_norm_g[i])
        if i < N_A_LAYERS:
            x = x + retention(h, ret_w_in[i], ret_w_out[i])
        else:
            j = i - N_A_LAYERS
            lambda_init = 0.8 - 0.6 * math.exp(-0.3 * i)
            x = x + diff_attention(h, k_sh, v_sh, diff_w_q[j], diff_lam_q1[j], diff_lam_k1[j],
                                   diff_lam_q2[j], diff_lam_k2[j], diff_subln_g[j], diff_w_o[j],
                                   lambda_init)
        h = rms_norm(x, ffn_norm_g[i])
        if i % 2 == 0:
            x = x + swiglu(h, ffn_w_gate[i // 2], ffn_w_up[i // 2], ffn_w_down[i // 2])
        else:
            x = x + moe_swiglu(h, moe_w_router[i // 2], moe_w_gate[i // 2],
                               moe_w_up[i // 2], moe_w_down[i // 2])
        if i == N_A_LAYERS - 1:
            k_sh, v_sh = shared_kv(x, kv_norm_g, w_kv)
    return rms_norm(x, final_norm_g)
```

```cpp
#include <hip/hip_runtime.h>
#include <hip/hip_bf16.h>
#include <cstdio>
#include <cstdint>
#include <cmath>

#ifndef WGM_SET
#define WGM_SET 8
#endif
namespace pg8 {
#define PG8_LAS __attribute__((address_space(3)))
typedef unsigned short bf16_t;
typedef short bf16x8 __attribute__((ext_vector_type(8)));
typedef float f32x4 __attribute__((ext_vector_type(4)));
typedef unsigned u32x4 __attribute__((ext_vector_type(4)));
typedef int i32x4 __attribute__((ext_vector_type(4)));
typedef int i32x8 __attribute__((ext_vector_type(8)));
constexpr int BM = 256, BK = 64, HALF = 128, HTB = HALF * BK * 2  , STAGE_BYTES = 8 * HTB, NXCD = 8, WGM = WGM_SET;

__host__ __device__ __forceinline__ int lds_byte(int r, int c) { const int st = (r >> 4) * 2 + (c >> 5), rr = r & 15, cc = c & 31, ob = rr * 64 + cc * 2; return st * 1024 + (ob ^ (((ob >> 9) & 1) << 5)); }
__host__ __device__ __forceinline__ void stage_rc(int b, int& R, int& C) { const int st = b / 1024, sb = b % 1024, swz = sb ^ (((sb >> 9) & 1) << 5); R = (st >> 1) * 16 + swz / 64; C = (st & 1) * 32 + (swz % 64) / 2; }
__host__ __device__ __forceinline__ int perm32(int rho) { const int n = rho >> 4, i = rho & 15; return 8 * (i >> 2) + 4 * n + (i & 3); }

struct Unit { const char* a; const char* b; int pm, pn; };
struct Shape { int lda, ldb, nt; int sclb = 0x7f7f7f7f, scla = 0x7f7f7f7f; float qscale = 1.f; };

struct TileOrder {
    int nM, nN, nwg, G, c;
    __device__ __forceinline__ void init(int nM_, int nN_, int G_, int c_) { nM = nM_; nN = nN_; nwg = nM * nN; G = G_; c = c_; }
    __device__ __forceinline__ bool tile(int i, int& pm, int& pn) const { const long L = (long)i * G + c; if (L >= nwg) return false; tileL((int)L, pm, pn); return true; }
    __device__ __forceinline__ void tileL(int L, int& pm, int& pn) const {
        int wgid = L; { const int q = nwg / NXCD, r = nwg % NXCD, xcd = wgid % NXCD, off = wgid / NXCD; wgid = (xcd < r ? xcd * (q + 1) : r * (q + 1) + (xcd - r) * q) + off; }
        const int nig = WGM * nN, gid = wgid / nig, fm = gid * WGM, gsz = (nM - fm) < WGM ? (nM - fm) : WGM;
        pm = fm + ((wgid % nig) % gsz); pn = (wgid % nig) / gsz;
    }
};

typedef float f32x2_t __attribute__((ext_vector_type(2))); typedef __bf16 bf16x2_t __attribute__((ext_vector_type(2)));
__device__ __forceinline__ unsigned cvt_pk_bf16(float lo, float hi) { f32x2_t v = {lo, hi}; bf16x2_t b = __builtin_convertvector(v, bf16x2_t); return __builtin_bit_cast(unsigned, b); }
__device__ __forceinline__ u32x4 pack8(const f32x4 v0, const f32x4 v1) { u32x4 w; w.x = cvt_pk_bf16(v0[0], v0[1]); w.y = cvt_pk_bf16(v0[2], v0[3]); w.z = cvt_pk_bf16(v1[0], v1[1]); w.w = cvt_pk_bf16(v1[2], v1[3]); return w; }

template <class E> struct epi_raw_i32 { static constexpr bool value = false; };
template <class Epi, class Sched, bool ALIGN_EPI, bool GATHER, bool F8 = false, bool I8 = false>
__device__ __forceinline__ void gemm_phase(PG8_LAS unsigned char* lds, const Shape g, const Sched& S, const Epi& E, const PG8_LAS int* idxc = nullptr) {
    int tid = threadIdx.x; asm volatile("" : "+v"(tid));
    const int wid = __builtin_amdgcn_readfirstlane(tid >> 6), lane = tid & 63, wr = wid >> 2, wc = wid & 3, fr = lane & 15, fq = lane >> 4;
    int nt = __builtin_amdgcn_readfirstlane(g.nt); asm volatile("" : "+s"(nt));
    int RA[2], CA[2];
    unsigned vB[2], vA[2], vAc[2][2], vAn[2][2];
#pragma unroll
    for (int i = 0; i < 2; ++i) { int R, C; stage_rc(tid * 16 + i * 8192, R, C); const int Rb = (R & ~31) + perm32(R & 31); RA[i] = R; CA[i] = C;
        vB[i] = (unsigned)(Rb * g.ldb + C) * 2u; vA[i] = (unsigned)(R * g.lda + C) * 2u;
#pragma unroll
        for (int h = 0; h < 2; ++h) { vAc[h][i] = 0u; vAn[h][i] = 0u; } }
    const size_t hsA = GATHER ? (size_t)0 : (size_t)HALF * g.lda * 2, hsB = (size_t)HALF * g.ldb * 2;
    const size_t kstep = (size_t)(BK * 2);
    const unsigned ldsw = (unsigned)wid * 1024u;
    const int aoff = lds_byte(wr * 64 + fr, fq * 8), boff = lds_byte(wc * 32 + fr, fq * 8);
#define PG8_SA(b, h) (((b) * 2 + (h)) * HTB)
#define PG8_SB(b, h) ((4 + (b) * 2 + (h)) * HTB)
#define PG8_STAGE(bufoff, gbase, voff) do { _Pragma("unroll") for (int _i = 0; _i < 2; ++_i) \
        __builtin_amdgcn_global_load_lds((const unsigned*)((const char*)(gbase) + (voff)[_i]), (PG8_LAS unsigned*)(lds + (bufoff) + ldsw + _i * 8192), 16, 0, 0); } while (0)
#define PG8_STB(b, h, gbase) PG8_STAGE(PG8_SB(b, h), (gbase) + (h) * hsB, vB)
#define PG8_STA(b, h, gbase, vg) do { if constexpr (GATHER) { PG8_STAGE(PG8_SA(b, h), gbase, (vg)[h]); } else { PG8_STAGE(PG8_SA(b, h), (gbase) + (h) * hsA, vA); } } while (0)
#define PG8_LDA(dst, b, h) do { _Pragma("unroll") for (int m = 0; m < 4; ++m) _Pragma("unroll") for (int k = 0; k < 2; ++k) dst[m][k] = *(const PG8_LAS bf16x8*)(lds + PG8_SA(b, h) + aoff + m * 2048 + k * 1024); } while (0)
#define PG8_LDB(dst, b, h) do { _Pragma("unroll") for (int n = 0; n < 2; ++n) _Pragma("unroll") for (int k = 0; k < 2; ++k) dst[n][k] = *(const PG8_LAS bf16x8*)(lds + PG8_SB(b, h) + boff + n * 2048 + k * 1024); } while (0)
#define PG8_CAT(x) __builtin_shufflevector(__builtin_bit_cast(i32x4, (x)[0]), __builtin_bit_cast(i32x4, (x)[1]), 0, 1, 2, 3, 4, 5, 6, 7)
#define PG8_MMA(ai, bj, At, Bt) do { __builtin_amdgcn_s_setprio(1); if constexpr (F8) { _Pragma("unroll") for (int m = 0; m < 4; ++m) _Pragma("unroll") for (int n = 0; n < 2; ++n) \
        asm volatile("v_mfma_scale_f32_16x16x128_f8f6f4 %0, %1, %2, %0, %3, %4 op_sel_hi:[0,0,0]" : "+v"(acc[ai][bj][m][n]) : "v"(PG8_CAT(Bt[n])), "v"(PG8_CAT(At[m])), "v"(sclb_), "v"(scla_)); } \
        else if constexpr (I8) { _Pragma("unroll") for (int m = 0; m < 4; ++m) _Pragma("unroll") for (int n = 0; n < 2; ++n) _Pragma("unroll") for (int k = 0; k < 2; ++k) \
        acc[ai][bj][m][n] = __builtin_bit_cast(f32x4, __builtin_amdgcn_mfma_i32_16x16x64_i8(__builtin_bit_cast(i32x4, Bt[n][k]), __builtin_bit_cast(i32x4, At[m][k]), __builtin_bit_cast(i32x4, acc[ai][bj][m][n]), 0, 0, 0)); } \
        else _Pragma("unroll") for (int m = 0; m < 4; ++m) _Pragma("unroll") for (int n = 0; n < 2; ++n) _Pragma("unroll") for (int k = 0; k < 2; ++k) \
        acc[ai][bj][m][n] = __builtin_amdgcn_mfma_f32_16x16x32_bf16(Bt[n][k], At[m][k], acc[ai][bj][m][n], 0, 0, 0); __builtin_amdgcn_s_setprio(0); } while (0)
#define PG8_WAIT_V(n) asm volatile("s_waitcnt vmcnt(" #n ")" ::: "memory")
#define PG8_WAIT_L(n) asm volatile("s_waitcnt lgkmcnt(" #n ")" ::: "memory")
#define PG8_BAR __builtin_amdgcn_s_barrier()
#define PG8_SCHED __builtin_amdgcn_sched_barrier(0)
#define PG8_GIDX(dst, ui_) do { if constexpr (GATHER) { _Pragma("unroll") for (int h = 0; h < 2; ++h) _Pragma("unroll") for (int i = 0; i < 2; ++i) \
        dst[h][i] = (unsigned)(idxc[(ui_) * 256 + HALF * h + RA[i]] * g.lda + CA[i]) * 2u; } } while (0)
    Unit cur, nxt; int ui = 0;
    if (!S.next(0, cur)) return;
    PG8_GIDX(vAc, 0);
    f32x4 acc[2][2][4][2];
#pragma unroll
    for (int a = 0; a < 2; ++a)
#pragma unroll
        for (int b = 0; b < 2; ++b)
#pragma unroll
            for (int m = 0; m < 4; ++m)
#pragma unroll
                for (int n = 0; n < 2; ++n) acc[a][b][m][n] = (f32x4){0.f, 0.f, 0.f, 0.f};
    bf16x8 At[4][2], B0[2][2], B1[2][2];
    const int sclb_ = g.sclb, scla_ = g.scla;
    const char* cA = cur.a; const char* cB = cur.b;
    PG8_STB(0, 0, cB); PG8_STB(0, 1, cB); PG8_STA(0, 0, cA, vAc); PG8_STA(0, 1, cA, vAc);
    if (wr == 1) PG8_BAR;
    PG8_WAIT_V(2); PG8_BAR;
    PG8_STB(1, 0, cB + kstep); PG8_STA(1, 0, cA + kstep, vAc); PG8_STB(1, 1, cB + kstep);
    PG8_WAIT_V(6); PG8_BAR;
    for (;;) {
        const bool has_next = S.next(ui + 1, nxt);
        const char* nA = has_next ? nxt.a : cA; const char* nB = has_next ? nxt.b : cB;
        if constexpr (GATHER) { if (has_next) { PG8_GIDX(vAn, ui + 1); } else {
#pragma unroll
            for (int h = 0; h < 2; ++h)
#pragma unroll
                for (int i = 0; i < 2; ++i) vAn[h][i] = vAc[h][i]; } }
        for (int t = 0; t < nt; t += 2) {
            const bool last = (t == nt - 2);
            const char* a1 = cA + (size_t)(t + 1) * kstep;
            const char* a2 = last ? nA : cA + (size_t)(t + 2) * kstep; const char* b2 = last ? nB : cB + (size_t)(t + 2) * kstep;
            const char* a3 = a2 + kstep; const char* b3 = b2 + kstep;
            unsigned vA2[2][2];
#pragma unroll
            for (int h = 0; h < 2; ++h)
#pragma unroll
                for (int i = 0; i < 2; ++i) vA2[h][i] = (GATHER && last) ? vAn[h][i] : vAc[h][i];
            PG8_LDB(B0, 0, 0); PG8_LDB(B1, 0, 1); PG8_SCHED; PG8_LDA(At, 0, 0); PG8_STA(1, 1, a1, vAc);
            PG8_WAIT_V(8); PG8_WAIT_L(0); PG8_BAR; PG8_MMA(0, 0, At, B0); PG8_MMA(0, 1, At, B1); PG8_BAR; PG8_SCHED;
            PG8_LDA(At, 0, 1); PG8_STB(0, 0, b2); PG8_STB(0, 1, b2); PG8_STA(0, 0, a2, vA2);
            PG8_WAIT_V(8); PG8_WAIT_L(0); PG8_BAR; PG8_MMA(1, 0, At, B0); PG8_MMA(1, 1, At, B1); PG8_BAR; PG8_SCHED;
            PG8_LDB(B0, 1, 0); PG8_LDB(B1, 1, 1); PG8_SCHED; PG8_LDA(At, 1, 0); PG8_STA(0, 1, a2, vA2);
            PG8_WAIT_V(8); PG8_WAIT_L(0); PG8_BAR; PG8_MMA(0, 0, At, B0); PG8_MMA(0, 1, At, B1); PG8_BAR; PG8_SCHED;
            PG8_LDA(At, 1, 1); PG8_STB(1, 0, b3); PG8_STB(1, 1, b3); PG8_STA(1, 0, a3, vA2);
            PG8_WAIT_V(8); PG8_WAIT_L(0); PG8_BAR; PG8_MMA(1, 0, At, B0); PG8_MMA(1, 1, At, B1); PG8_BAR; PG8_SCHED;
        }
        if constexpr (I8 && !epi_raw_i32<Epi>::value) { const float qs = g.qscale;
            _Pragma("unroll") for (int a = 0; a < 2; ++a) _Pragma("unroll") for (int b = 0; b < 2; ++b) _Pragma("unroll") for (int m = 0; m < 4; ++m) _Pragma("unroll") for (int n = 0; n < 2; ++n) _Pragma("unroll") for (int i = 0; i < 4; ++i)
                { const float t_ = acc[a][b][m][n][i]; acc[a][b][m][n][i] = (float)__builtin_bit_cast(int, t_) * qs; } }
        if constexpr (F8) asm volatile("s_nop 15" ::: "memory");
        if constexpr (ALIGN_EPI) { if (wr == 0) PG8_BAR; }
        { int fr_ = fr, fq_ = fq, wr_ = wr, wc_ = wc; asm volatile("" : "+v"(fr_), "+v"(fq_), "+s"(wr_), "+s"(wc_));
          E(acc, cur, wr_, wc_, fr_, fq_); }
        if (!has_next) break;
#pragma unroll
        for (int a = 0; a < 2; ++a)
#pragma unroll
            for (int b = 0; b < 2; ++b)
#pragma unroll
                for (int m = 0; m < 4; ++m)
#pragma unroll
                    for (int n = 0; n < 2; ++n) acc[a][b][m][n] = (f32x4){0.f, 0.f, 0.f, 0.f};
        cur = nxt; cA = nA; cB = nB; ++ui;
        if constexpr (GATHER) {
#pragma unroll
            for (int h = 0; h < 2; ++h)
#pragma unroll
                for (int i = 0; i < 2; ++i) vAc[h][i] = vAn[h][i]; }
        if constexpr (ALIGN_EPI) { if (wr == 1) PG8_BAR; }
    }
    PG8_WAIT_V(0);
    if constexpr (!ALIGN_EPI) { if (wr == 0) PG8_BAR; }
    PG8_BAR;
#undef PG8_SA
#undef PG8_SB
#undef PG8_STAGE
#undef PG8_STA
#undef PG8_STB
#undef PG8_LDA
#undef PG8_LDB
#undef PG8_MMA
#undef PG8_CAT
#undef PG8_WAIT_V
#undef PG8_WAIT_L
#undef PG8_BAR
#undef PG8_SCHED
#undef PG8_GIDX
}
}

#include <hip/hip_bf16.h>
#include <cmath>
namespace attn_body {
using bf16=__hip_bfloat16;
using bf16x8=__attribute__((ext_vector_type(8)))short;
using s16x4=__attribute__((ext_vector_type(4)))short;
using f32x16=__attribute__((ext_vector_type(16)))float;
using u32x4=__attribute__((ext_vector_type(4)))unsigned;
constexpr int BATCH=2,NHEAD=16,SEQ=16384,D=64,DM=NHEAD*D;
#ifndef ATTN_FAST_LIM
#define ATTN_FAST_LIM 3600.f
#endif
constexpr int NW=8,QBLK=32,QB=QBLK*NW,KVBLK=64,NQB=SEQ/QB;
constexpr int ATTN_PITCH=DM, ATTN_UNIT_ROWS=QB;
__device__ __forceinline__ int crow(int r,int hi){return (r&3)+8*(r>>2)+4*hi;}
#define SBAR() __builtin_amdgcn_sched_barrier(0)
__device__ __forceinline__ void cmask(f32x16&p0,f32x16&p1,int jb,int qrel,int hi){
  const float NEG=-INFINITY; int kb=64*jb+4*hi;
  #pragma unroll
  for(int r=0;r<16;++r){int kv=kb+(r&3)+8*(r>>2); if(kv>qrel)p0[r]=NEG; if(kv+32>qrel)p1[r]=NEG;}
}

constexpr int NSLOT=3, SLOTB=8192, DV=128;
constexpr int LDS_K=0, LDS_V=NSLOT*SLOTB, LDS_WS=3*NSLOT*SLOTB, LDS_OST=LDS_WS+NW*64*4, LDS_BYTES=LDS_OST+NW*4096;
constexpr float C2=0.125f*1.4426950408889634f;
__device__ __forceinline__ void glds16(const void*gsrc,unsigned lds_dst){unsigned keep;
  asm volatile("s_mov_b32 %0, m0\n\ts_mov_b32 m0, %2\n\ts_nop 0\n\tglobal_load_lds_dwordx4 %1, off\n\ts_mov_b32 m0, %0":"=&s"(keep):"v"(gsrc),"s"(lds_dst):"memory");}
__device__ __forceinline__ float max3f(float a,float b,float c){float r;asm("v_max3_f32 %0, %1, %2, %3":"=v"(r):"v"(a),"v"(b),"v"(c));return r;}
__device__ __forceinline__ float max2f(float a,float b){float r;asm("v_max_f32_e32 %0, %1, %2":"=v"(r):"v"(a),"v"(b));return r;}
__device__ __forceinline__ float fadd_s(float a,float b){float r;asm("v_add_f32_e32 %0, %1, %2":"=v"(r):"v"(a),"v"(b));return r;}
__device__ __forceinline__ float fsub_s(float a,float b){float r;asm("v_sub_f32_e32 %0, %1, %2":"=v"(r):"v"(a),"v"(b));return r;}
typedef float f32x2_t __attribute__((ext_vector_type(2))); typedef __bf16 bf16x2_t __attribute__((ext_vector_type(2)));
__device__ __forceinline__ unsigned cvtpk_s(float lo,float hi){f32x2_t v={lo,hi};bf16x2_t b=__builtin_convertvector(v,bf16x2_t);return __builtin_bit_cast(unsigned,b);}
__device__ __forceinline__ unsigned pk4_i8a(float a,float b,float c,float d){
  const unsigned u0=__builtin_bit_cast(unsigned,__builtin_amdgcn_fmed3f(a,-127.f,127.f)+12582912.f),u1=__builtin_bit_cast(unsigned,__builtin_amdgcn_fmed3f(b,-127.f,127.f)+12582912.f);
  const unsigned u2=__builtin_bit_cast(unsigned,__builtin_amdgcn_fmed3f(c,-127.f,127.f)+12582912.f),u3=__builtin_bit_cast(unsigned,__builtin_amdgcn_fmed3f(d,-127.f,127.f)+12582912.f);
  return __builtin_amdgcn_perm(u1,u0,0x0c0c0400u)|__builtin_amdgcn_perm(u3,u2,0x04000c0cu);}
#define WAIT_BAR(N) asm volatile("s_waitcnt vmcnt(" #N ") lgkmcnt(0)\n\ts_barrier":::"memory")

__device__ __forceinline__ void qkt(f32x16&p0,f32x16&p1,const char*Kslot,const bf16x8*qr,int r32,int hi){ const f32x16 negm=f32x16{};
  const char*kb=Kslot+hi*1024+r32*16;
  #pragma unroll
  for(int d0=0;d0<4;++d0){
    const bf16x8 b0=*reinterpret_cast<const bf16x8*>(kb+d0*2048);
    const bf16x8 b1=*reinterpret_cast<const bf16x8*>(kb+d0*2048+512);
    if(d0==0){p0=__builtin_amdgcn_mfma_f32_32x32x16_bf16(b0,qr[0],negm,0,0,0);p1=__builtin_amdgcn_mfma_f32_32x32x16_bf16(b1,qr[0],negm,0,0,0);}
    else{p0=__builtin_amdgcn_mfma_f32_32x32x16_bf16(b0,qr[d0],p0,0,0,0);p1=__builtin_amdgcn_mfma_f32_32x32x16_bf16(b1,qr[d0],p1,0,0,0);}}
}
typedef __attribute__((address_space(3))) const char* lds_cptr;
typedef short v4i16_t __attribute__((ext_vector_type(4)));
__device__ __forceinline__ void kload8(bf16x8*kf,lds_cptr kp){
  kf[0]=*(const __attribute__((address_space(3))) bf16x8*)(kp);      kf[1]=*(const __attribute__((address_space(3))) bf16x8*)(kp+512);
  kf[2]=*(const __attribute__((address_space(3))) bf16x8*)(kp+2048); kf[3]=*(const __attribute__((address_space(3))) bf16x8*)(kp+2560);
  kf[4]=*(const __attribute__((address_space(3))) bf16x8*)(kp+4096); kf[5]=*(const __attribute__((address_space(3))) bf16x8*)(kp+4608);
  kf[6]=*(const __attribute__((address_space(3))) bf16x8*)(kp+6144); kf[7]=*(const __attribute__((address_space(3))) bf16x8*)(kp+6656);
}
__device__ __forceinline__ void kload2(bf16x8*kf,lds_cptr kp,int j){ kf[2*j]=*(const __attribute__((address_space(3))) bf16x8*)(kp+j*2048); kf[2*j+1]=*(const __attribute__((address_space(3))) bf16x8*)(kp+j*2048+512); }
__device__ __forceinline__ s16x4 vtr(lds_cptr p){ return __builtin_bit_cast(s16x4,__builtin_amdgcn_ds_read_tr16_b64_v4i16((__attribute__((address_space(3))) v4i16_t*)p)); }
__device__ __forceinline__ float rowmax(const f32x16&p0,const f32x16&p1){
  float a=max3f(p0[0],p0[1],p1[0]),b=max3f(p0[2],p0[3],p1[1]);a=max3f(a,p1[2],p1[3]);
  #pragma unroll
  for(int r=4;r<16;r+=4){a=max3f(a,p0[r],p0[r+1]);b=max3f(b,p0[r+2],p0[r+3]);a=max3f(a,p1[r],p1[r+1]);b=max3f(b,p1[r+2],p1[r+3]);}
  const float m=max2f(a,b);
  auto rr=__builtin_amdgcn_permlane32_swap(__float_as_uint(m),__float_as_uint(m),false,false);
  return max2f(__uint_as_float(rr[0]),__uint_as_float(rr[1]));
}
__device__ __forceinline__ void pv(f32x16*o,int vb,bf16x8 pa0,bf16x8 pa1,bf16x8 pa2,bf16x8 pa3){
  #pragma unroll
  for(int d0=0;d0<4;++d0){s16x4 lo[4],hi[4];
    #pragma unroll
    for(int ks=0;ks<4;++ks){
      asm volatile("ds_read_b64_tr_b16 %0,%1 offset:%c2":"=&v"(lo[ks]):"v"(vb),"i"(d0*4096+ks*1024):"memory");
      asm volatile("ds_read_b64_tr_b16 %0,%1 offset:%c2":"=&v"(hi[ks]):"v"(vb),"i"(d0*4096+ks*1024+512):"memory");}
    asm volatile("s_waitcnt lgkmcnt(0)":::"memory");SBAR();
    #define PK(k) (bf16x8){lo[k][0],lo[k][1],lo[k][2],lo[k][3],hi[k][0],hi[k][1],hi[k][2],hi[k][3]}
    o[d0]=__builtin_amdgcn_mfma_f32_32x32x16_bf16(pa0,PK(0),o[d0],0,0,0);
    o[d0]=__builtin_amdgcn_mfma_f32_32x32x16_bf16(pa1,PK(1),o[d0],0,0,0);
    o[d0]=__builtin_amdgcn_mfma_f32_32x32x16_bf16(pa2,PK(2),o[d0],0,0,0);
    o[d0]=__builtin_amdgcn_mfma_f32_32x32x16_bf16(pa3,PK(3),o[d0],0,0,0);
    #undef PK
  }
}

#ifndef ATTN_STORE16
#define ATTN_STORE16(p,v) (*(u32x4*)(p)=(v))
#endif
template<int THRL,bool FAST> __device__ __forceinline__ void attn_unit(int b,int h,int p,int qb,const bf16*Q,const bf16*__restrict__ K,const bf16*__restrict__ V,bf16*O,char*shm){
  int tid=threadIdx.x; asm volatile("":"+v"(tid));
  const int lane=tid&63,r32=lane&31,hi=lane>>5; const int wid=__builtin_amdgcn_readfirstlane(tid>>6);
  const long rowbase=(long)b*SEQ; const int q0=qb*QB;
  const int hq=2*h+p; const bf16*Qw=Q+(rowbase+q0+wid*QBLK)*DM+hq*D;
  const bf16*Kh=K+rowbase*DM+hq*D,*Vh=V+rowbase*DM+h*DV;
  const unsigned lds0=(unsigned)(uintptr_t)shm;
  float*wsf=(float*)(shm+LDS_WS)+wid*64;
  const bf16*ksrc=Kh+(long)lane*DM+wid*8;
  const bf16*vsrc=Vh+(long)(16*(wid&3)+(lane>>2))*DM+(wid>>2)*32+(lane&3)*8;
  const unsigned kdst=lds0+LDS_K+wid*1024, vdst=lds0+LDS_V+wid*1024;
  #define DMA_K(t,slot) glds16(ksrc+(long)(t)*KVBLK*DM,(unsigned)__builtin_amdgcn_readfirstlane(kdst+(slot)))
  #define DMA_V(t,slot) do{ glds16(vsrc+(long)(t)*KVBLK*DM,(unsigned)__builtin_amdgcn_readfirstlane(vdst+2*(slot))); glds16(vsrc+(long)(t)*KVBLK*DM+64,(unsigned)__builtin_amdgcn_readfirstlane(vdst+2*(slot)+8192)); }while(0)
  const int vb0=(int)(lds0+LDS_V)+((lane>>4)&1)*32+(lane&3)*8+(4*hi+((lane&15)>>2))*64;
  const char*Kbase=shm+LDS_K; bf16x8 kf[8];
  const lds_cptr shm3=(lds_cptr)shm; const lds_cptr kp0=shm3+LDS_K+hi*1024+r32*16; const lds_cptr vp0=shm3+LDS_V+((lane>>4)&1)*32+(lane&3)*8+(4*hi+((lane&15)>>2))*64;
  const int NT=(q0+QB)/KVBLK;
  DMA_K(0,0);DMA_V(0,0);DMA_K(1,SLOTB);
  bf16x8 qr[4];
  #pragma unroll
  for(int d0=0;d0<4;++d0)qr[d0]=*reinterpret_cast<const bf16x8*>(&Qw[(long)r32*DM+d0*16+hi*8]);
  float mhat=0.f,l_reg=0.f;f32x16 o[4];o[0]=f32x16{};o[1]=f32x16{};o[2]=f32x16{};o[3]=f32x16{};
  const int qrel=wid*QBLK+r32;
  #define CMASK(P0,P1,t) do{int jb_=(t)-(NT-4); if(jb_>=0)cmask(P0,P1,jb_,qrel,hi);}while(0)
  bool resc=false;
  #define START(P0,P1) do{ if constexpr(!FAST){ const float rm=rowmax(P0,P1); resc=false; \
    { const float dl=rm; mhat=fadd_s(mhat,dl); \
      _Pragma("unroll") for(int r=0;r<16;++r){P0[r]=fsub_s(P0[r],dl);P1[r]=fsub_s(P1[r],dl);} \
      } } \
    _Pragma("unroll") for(int r=0;r<16;++r)P0[r]=__builtin_amdgcn_exp2f(P0[r]); }while(0)
  #define RESC() do{ if constexpr(!FAST){ if(resc){ asm volatile("s_waitcnt lgkmcnt(0)":::"memory"); \
      _Pragma("unroll") for(int d_=0;d_<4;++d_) _Pragma("unroll") for(int r=0;r<16;++r)o[d_][r]*=wsf[crow(r,hi)]; } } }while(0)
  f32x16 pA0,pA1,pB0,pB1;
  int sl_prev=0,sl_cur=0,sl_next=SLOTB;
  #define ROT() do{sl_prev=sl_cur;sl_cur=sl_next;sl_next=(sl_next==(NSLOT-1)*SLOTB)?0:sl_next+SLOTB;}while(0)
  DMA_K(2,2*SLOTB);
  WAIT_BAR(4);
  qkt(pA0,pA1,Kbase,qr,r32,hi);asm volatile("s_nop 15\n\ts_nop 7":"+v"(pA0),"+v"(pA1));CMASK(pA0,pA1,0);
  START(pA0,pA1);
  _Pragma("unroll") for(int r=0;r<16;++r)pA1[r]=__builtin_amdgcn_exp2f(pA1[r]);
  WAIT_BAR(0);
  DMA_K(3,0);DMA_V(1,SLOTB);
  ROT();
  kload8(kf,kp0+sl_cur);
  WAIT_BAR(3);
  s16x4 vlo[16],vhi[16]; u32x4 pw0,pw1,pw2,pw3;
  #define PKW(P,B) cvtpk_s(P[B],P[B+1])
  #define PAF(k) __builtin_bit_cast(bf16x8,pw##k)
  #define VFR(i) (bf16x8){vlo[i][0],vlo[i][1],vlo[i][2],vlo[i][3],vhi[i][0],vhi[i][1],vhi[i][2],vhi[i][3]}
  #define PIN(x) asm volatile("":"+v"(x))
  #define MX3(a,b,c) __builtin_fmaxf(__builtin_fmaxf((a),(b)),(c))
  #define GAPA(MF,A0,A1,A2,A3,W0,W1,PW) do{ MF; sacc+=A0; sacc+=A1; sacc+=A2; sacc+=A3; PIN(sacc); W0; W1; PIN(PW); SBAR(); }while(0)
  #define EX(v) __builtin_amdgcn_exp2f(v)
  #define ZERO16 (f32x16{})
  #define GAPB(MF,X,B) do{ MF; if constexpr(FAST){X[B]=EX(X[B]); X[B+1]=EX(X[B+1]);}else{X[B]=EX(X[B]-mhat); X[B+1]=EX(X[B+1]-mhat);} PIN(X); SBAR(); }while(0)
  #define VRD(i) do{ vlo[i]=vtr(vp_+(((i)>>2)*4096+((i)&3)*1024)); vhi[i]=vtr(vp_+(((i)>>2)*4096+((i)&3)*1024+512)); }while(0)
  #define KRD(G,j) do{ if(G){ kload2(kf,kp0+sl_next,j); SBAR(); } }while(0)
  #define STEP(C0,C1,P0,P1,t,GK,GV,GL) do{ SBAR(); \
    const lds_cptr vp_=vp0+2*sl_prev; \
    float sacc=(P0[0]+P0[1]); \
    GAPA(C0=__builtin_amdgcn_mfma_f32_32x32x16_bf16(kf[0],qr[0],ZERO16,0,0,0), P0[2],P0[3],P0[4],P0[5],     pw0[0]=PKW(P0,0), pw0[1]=PKW(P0,2), pw0); \
    GAPA(C1=__builtin_amdgcn_mfma_f32_32x32x16_bf16(kf[1],qr[0],ZERO16,0,0,0), P0[6],P0[7],P0[8],P0[9],     pw0[2]=PKW(P0,4), pw0[3]=PKW(P0,6), pw0); \
    VRD(0); SBAR(); GAPA(C0=__builtin_amdgcn_mfma_f32_32x32x16_bf16(kf[2],qr[1],C0,0,0,0),   P0[10],P0[11],P0[12],P0[13], pw1[0]=PKW(P0,8), pw1[1]=PKW(P0,10), pw1); \
    VRD(4); SBAR(); GAPA(C1=__builtin_amdgcn_mfma_f32_32x32x16_bf16(kf[3],qr[1],C1,0,0,0),   P0[14],P0[15],P1[0],P1[1],   pw1[2]=PKW(P0,12),pw1[3]=PKW(P0,14), pw1); \
    VRD(8); SBAR(); GAPA(C0=__builtin_amdgcn_mfma_f32_32x32x16_bf16(kf[4],qr[2],C0,0,0,0),   P1[2],P1[3],P1[4],P1[5],     pw2[0]=PKW(P1,0), pw2[1]=PKW(P1,2), pw2); \
    VRD(12); SBAR(); GAPA(C1=__builtin_amdgcn_mfma_f32_32x32x16_bf16(kf[5],qr[2],C1,0,0,0),   P1[6],P1[7],P1[8],P1[9],     pw2[2]=PKW(P1,4), pw2[3]=PKW(P1,6), pw2); \
    VRD(1); SBAR(); GAPA(C0=__builtin_amdgcn_mfma_f32_32x32x16_bf16(kf[6],qr[3],C0,0,0,0),   P1[10],P1[11],P1[12],P1[13], pw3[0]=PKW(P1,8), pw3[1]=PKW(P1,10), pw3); \
    VRD(5); SBAR(); GAPA(C1=__builtin_amdgcn_mfma_f32_32x32x16_bf16(kf[7],qr[3],C1,0,0,0),   P1[14],P1[15],0.f,0.f,       pw3[2]=PKW(P1,12),pw3[3]=PKW(P1,14), pw3); \
    l_reg+=sacc; \
    if(GK){DMA_K((t)+3,sl_cur);} if(GV){DMA_V((t)+1,sl_next);} \
    CMASK(C0,C1,t); \
    if constexpr(!FAST){ float a=MX3(C0[0],C0[1],C1[0]),b=MX3(C0[2],C0[3],C1[1]); a=MX3(a,C1[2],C1[3]); \
      _Pragma("unroll") for(int r=4;r<16;r+=4){a=MX3(a,C0[r],C0[r+1]);b=MX3(b,C0[r+2],C0[r+3]);a=MX3(a,C1[r],C1[r+1]);b=MX3(b,C1[r+2],C1[r+3]);} \
      float rm=__builtin_fmaxf(a,b); { auto rr=__builtin_amdgcn_permlane32_swap(__float_as_uint(rm),__float_as_uint(rm),false,false); rm=__builtin_fmaxf(__uint_as_float(rr[0]),__uint_as_float(rr[1])); } \
      resc=false; \
      rm-=mhat; \
      if(__builtin_expect(__any(rm>(float)THRL),0)){ const float dl=__builtin_fmaxf(rm,0.f); mhat+=dl; \
        const float f=__builtin_amdgcn_exp2f(-dl); l_reg*=f; if(hi==0)wsf[r32]=f; resc=true; } } \
    SBAR(); \
    VRD(9); SBAR(); GAPB(o[0]=__builtin_amdgcn_mfma_f32_32x32x16_bf16(PAF(0),VFR(0),o[0],0,0,0), C0,0); \
    VRD(13); SBAR(); GAPB(o[1]=__builtin_amdgcn_mfma_f32_32x32x16_bf16(PAF(0),VFR(4),o[1],0,0,0), C0,2); \
    VRD(2); SBAR(); GAPB(o[2]=__builtin_amdgcn_mfma_f32_32x32x16_bf16(PAF(0),VFR(8),o[2],0,0,0), C0,4); \
    VRD(6); SBAR(); GAPB(o[3]=__builtin_amdgcn_mfma_f32_32x32x16_bf16(PAF(0),VFR(12),o[3],0,0,0), C0,6); \
    VRD(10); SBAR(); GAPB(o[0]=__builtin_amdgcn_mfma_f32_32x32x16_bf16(PAF(1),VFR(1),o[0],0,0,0), C0,8); \
    VRD(14); SBAR(); GAPB(o[1]=__builtin_amdgcn_mfma_f32_32x32x16_bf16(PAF(1),VFR(5),o[1],0,0,0), C0,10); \
    VRD(3); SBAR(); GAPB(o[2]=__builtin_amdgcn_mfma_f32_32x32x16_bf16(PAF(1),VFR(9),o[2],0,0,0), C0,12); \
    VRD(7); SBAR(); GAPB(o[3]=__builtin_amdgcn_mfma_f32_32x32x16_bf16(PAF(1),VFR(13),o[3],0,0,0), C0,14); \
    VRD(11); SBAR(); GAPB(o[0]=__builtin_amdgcn_mfma_f32_32x32x16_bf16(PAF(2),VFR(2),o[0],0,0,0), C1,0); \
    VRD(15); SBAR(); GAPB(o[1]=__builtin_amdgcn_mfma_f32_32x32x16_bf16(PAF(2),VFR(6),o[1],0,0,0), C1,2); \
    KRD(GL,0); GAPB(o[2]=__builtin_amdgcn_mfma_f32_32x32x16_bf16(PAF(2),VFR(10),o[2],0,0,0), C1,4); \
    KRD(GL,1); GAPB(o[3]=__builtin_amdgcn_mfma_f32_32x32x16_bf16(PAF(2),VFR(14),o[3],0,0,0), C1,6); \
    KRD(GL,2); GAPB(o[0]=__builtin_amdgcn_mfma_f32_32x32x16_bf16(PAF(3),VFR(3),o[0],0,0,0), C1,8); \
    KRD(GL,3); GAPB(o[1]=__builtin_amdgcn_mfma_f32_32x32x16_bf16(PAF(3),VFR(7),o[1],0,0,0), C1,10); \
    GAPB(o[2]=__builtin_amdgcn_mfma_f32_32x32x16_bf16(PAF(3),VFR(11),o[2],0,0,0), C1,12); \
    GAPB(o[3]=__builtin_amdgcn_mfma_f32_32x32x16_bf16(PAF(3),VFR(15),o[3],0,0,0), C1,14); \
    }while(0)
  int t=1;
  #undef CMASK
  #define CMASK(P0,P1,t) do{}while(0)
  for(;t+5<NT;t+=2){
    STEP(pB0,pB1,pA0,pA1,t,true,true,true);     WAIT_BAR(3); RESC(); ROT();
    STEP(pA0,pA1,pB0,pB1,t+1,true,true,true);   WAIT_BAR(3); RESC(); ROT();
  }
  #undef CMASK
  #define CMASK(P0,P1,t) do{int jb_=(t)-(NT-4); if(jb_>=0)cmask(P0,P1,jb_,qrel,hi);}while(0)
  #define ENDW(tt) do{ if((tt)+3<NT){WAIT_BAR(3);} else if((tt)+2<NT){WAIT_BAR(2);} else {WAIT_BAR(0);} }while(0)
  for(;t+1<NT;t+=2){
    STEP(pB0,pB1,pA0,pA1,t,(t+3<NT),(t+1<NT),(t+1<NT));       ENDW(t);   RESC(); ROT();
    STEP(pA0,pA1,pB0,pB1,t+1,(t+4<NT),(t+2<NT),(t+2<NT));     ENDW(t+1); RESC(); ROT();
  }
  STEP(pB0,pB1,pA0,pA1,NT-1,false,false,false); RESC();
  { float sacc=pB0[0]+pB0[1]; _Pragma("unroll") for(int r=2;r<16;++r)sacc+=pB0[r]; _Pragma("unroll") for(int r=0;r<16;++r)sacc+=pB1[r]; l_reg+=sacc;
    pw0=(u32x4){PKW(pB0,0),PKW(pB0,2),PKW(pB0,4),PKW(pB0,6)};pw1=(u32x4){PKW(pB0,8),PKW(pB0,10),PKW(pB0,12),PKW(pB0,14)};pw2=(u32x4){PKW(pB1,0),PKW(pB1,2),PKW(pB1,4),PKW(pB1,6)};pw3=(u32x4){PKW(pB1,8),PKW(pB1,10),PKW(pB1,12),PKW(pB1,14)};
    SBAR(); pv(o,vb0+2*sl_cur,PAF(0),PAF(1),PAF(2),PAF(3)); }
  #undef PKW
  #undef PAF
  #undef VFR
  #undef PIN
  #undef MX3
  #undef GAPA
  #undef GAPB
  #undef EX
  #undef VRD
  #undef KRD
  #undef STEP
  #undef ENDW
  {auto rr=__builtin_amdgcn_permlane32_swap(__float_as_uint(l_reg),__float_as_uint(l_reg),false,false);l_reg=__uint_as_float(rr[0])+__uint_as_float(rr[1]);}
  if(hi==0)wsf[32+r32]=l_reg;asm volatile("s_waitcnt lgkmcnt(0)":::"memory");
  float rli[16];
  #pragma unroll
  for(int r=0;r<16;++r)rli[r]=__builtin_amdgcn_rcpf(wsf[32+crow(r,hi)]);
  bf16*Ow=O+(rowbase+q0+wid*QBLK)*DM+h*DV;
  { bf16*stg=(bf16*)(shm+LDS_OST)+wid*2048;
    #pragma unroll
    for(int hf=0;hf<2;++hf){
      #pragma unroll
      for(int r=0;r<16;++r){const int orow=crow(r,hi);
        #pragma unroll
        for(int d0=0;d0<2;++d0)stg[orow*64+d0*32+r32]=__float2bfloat16(o[2*hf+d0][r]*rli[r]);}
      asm volatile("s_waitcnt lgkmcnt(0)":::"memory");
      #pragma unroll
      for(int i=0;i<4;++i){const int row=i*8+(lane>>3),ch=lane&7; const u32x4 v=*(const u32x4*)(stg+row*64+ch*8); ATTN_STORE16(Ow+(long)row*DM+hf*64+ch*8,v);}
      asm volatile("s_waitcnt lgkmcnt(0)":::"memory"); } }
  asm volatile("s_waitcnt lgkmcnt(0)\n\ts_barrier":::"memory");
  #undef DMA_K
  #undef DMA_V
  #undef CMASK
  #undef START
  #undef RESC
  #undef ROT
}
constexpr int ATTN_LDS_BYTES=LDS_BYTES;
template<int THRL=8> __device__ __forceinline__ void attn_phase(char*lds,const bf16*Q,const bf16*K,const bf16*V,bf16*OS0,bf16*OS1,bf16*OB,const unsigned*nrm,float lam,const float*subg,float oscale,float sub_eps,int vcu,int G){
  for(int item=vcu;item<16*32;item+=G){
    const int bh=item>>5,pr=item&31; const int b=bh>>3,h=bh&7;
    for(int j=0;j<2;++j){ const int qb=j?pr:63-pr;
      for(int p=0;p<2;++p){
        const float k2=__uint_as_float(__builtin_amdgcn_readfirstlane(nrm[b*16+2*h+p])),q2=__uint_as_float(__builtin_amdgcn_readfirstlane(nrm[(2+b)*16+2*h+p]));
        const bool fast=(k2*q2<=ATTN_FAST_LIM);
        if(fast)attn_unit<THRL,true>(b,h,p,qb,Q,K,V,p?OS1:OS0,lds); else attn_unit<THRL,false>(b,h,p,qb,Q,K,V,p?OS1:OS0,lds); }
      { int tid=threadIdx.x; asm volatile("":"+v"(tid)); const int lane=tid&63,wid=tid>>6;
        asm volatile("s_waitcnt vmcnt(0)":::"memory");
        const long row0=(long)b*SEQ+qb*QB+wid*QBLK; const int col=h*DV+(lane&7)*16;
        #pragma unroll
        for(int i=0;i<4;++i){ const long off=(row0+i*8+(lane>>3))*DM+col;
          const u32x4 a0=*(const u32x4*)(OS0+off),a1=*(const u32x4*)(OS0+off+8),b0=*(const u32x4*)(OS1+off),b1=*(const u32x4*)(OS1+off+8);
          float y[16]; float ss=0.f;
          #pragma unroll
          for(int q=0;q<4;++q){ y[2*q]=__uint_as_float(a0[q]<<16)-lam*__uint_as_float(b0[q]<<16); y[2*q+1]=__uint_as_float(a0[q]&0xffff0000u)-lam*__uint_as_float(b0[q]&0xffff0000u);
            y[8+2*q]=__uint_as_float(a1[q]<<16)-lam*__uint_as_float(b1[q]<<16); y[8+2*q+1]=__uint_as_float(a1[q]&0xffff0000u)-lam*__uint_as_float(b1[q]&0xffff0000u); }
          #pragma unroll
          for(int q=0;q<16;++q)ss+=y[q]*y[q];
          ss+=__shfl_xor(ss,1);ss+=__shfl_xor(ss,2);ss+=__shfl_xor(ss,4);
          const float rs=__builtin_amdgcn_rsqf(ss*(1.f/128.f)+sub_eps)*oscale;
          u32x4 o0;
          #pragma unroll
          for(int q=0;q<4;++q){ const float* gp=subg+(lane&7)*16+4*q; o0[q]=pk4_i8a(y[4*q]*rs*gp[0],y[4*q+1]*rs*gp[1],y[4*q+2]*rs*gp[2],y[4*q+3]*rs*gp[3]); }
          *(u32x4*)((unsigned char*)OB+off)=o0; } }
    }
  }
}
#undef SBAR
#undef WAIT_BAR
}
constexpr int NWAVES = 8;
constexpr int BATCH = 2, SEQ = 16384, TOK = BATCH * SEQ, DM = 1024;
constexpr int RH = 4, RC = 512, NCH = SEQ / RC, PXP = RC + 256, VTP = NCH * PXP;
constexpr int DFF = 2816, NE = 8, DFE = 3584;
constexpr int MAXMT = TOK / 256 + NE, SLOTS = MAXMT * 256;
constexpr float NORM_EPS = 1e-6f, SUBLN_EPS = 1e-5f, LAMBDA_INIT = 0.35550906759096934f;
constexpr float L2THETA = 13.287712379549449f, INV2PI = 0.15915494309189535f;
constexpr float ASC8 = 4.f, WDSC8 = 512.f;
constexpr int E8_ACT = 0x7d7d7d7d, E8_WD = 0x76767676;
constexpr float ASCI = 16.f, WDSCI_D = 3000.f, WDSCI_M = 3380.f;
constexpr float OSCI = 40.f, WOSCI = 1800.f;
constexpr float XSCI = 25.f, WSCI = 900.f;
constexpr float C2Q = 0.18033688011112042f;

constexpr size_t MiB = 1u << 20;
constexpr size_t WS_CTL = 0, CTL_ZERO_BYTES = 1 * MiB;
constexpr size_t WS_PART = 1 * MiB;
constexpr size_t WS_WIN = 1 * MiB;
constexpr size_t WS_WOUT = 13 * MiB;
constexpr size_t WS_WGU = 17 * MiB;
constexpr size_t WS_WD = 28 * MiB;
constexpr size_t WS_WKVQ = 33 * MiB + MiB / 2;
constexpr size_t WS_WO = 39 * MiB + MiB / 2;
constexpr size_t WS_SSP = 42 * MiB;
constexpr size_t WS_TOKE = 44 * MiB;
constexpr size_t WS_TOKW = WS_TOKE + 256 * 1024;
constexpr size_t WS_TOKR = WS_TOKW + 256 * 1024;
constexpr size_t WS_HIST = WS_TOKR + 128 * 1024;
constexpr size_t WS_SLOTT = 45 * MiB;
constexpr size_t WS_SLOTW = 45 * MiB + 512 * 1024;
constexpr size_t WS_XB = 50 * MiB;
constexpr size_t WS_OG = 114 * MiB;
constexpr size_t WS_QT = 242 * MiB, WS_KT = 274 * MiB, WS_KTT = 306 * MiB, WS_VTE = 338 * MiB, WS_PEX = 434 * MiB;
constexpr size_t WS_ACT = 114 * MiB;
constexpr size_t WS_O0 = 50 * MiB, WS_K = 114 * MiB, WS_V = 178 * MiB, WS_Q = 242 * MiB, WS_OB = 242 * MiB, WS_O1 = 306 * MiB;
constexpr size_t WS_ACTM = 114 * MiB, WS_Y = 236 * MiB, WS_WMGU = 380 * MiB, WS_WMD = 464 * MiB;
constexpr size_t WS_TOKS = WS_HIST + 64 * 1024;
constexpr size_t WS_OB8 = 370 * MiB;
constexpr size_t WS_END = 530 * MiB;
static_assert(WS_PEX + (size_t)RH * SEQ * PXP * 2 <= WS_END && WS_VTE + (size_t)2048 * VTP * 2 <= WS_PEX && WS_ACTM + (size_t)SLOTS * DFE <= WS_Y && WS_Y + (size_t)2 * SLOTS * DM * 2 <= WS_WMGU && WS_WMGU + (size_t)NE * 7168 * DM <= WS_WMD && WS_TOKS + (size_t)TOK * 8 <= WS_SLOTT && WS_WMD + (size_t)NE * 1024 * DFE * 2 <= WS_END, "d_ws map");
constexpr int CW_TMO = 0, CW_CODE = 1, CW_NRM = 512, CW_BAR = 4096;

constexpr int RING_OFF = 0, RING_BYTES = 131072;
constexpr int MISC_OFF = RING_BYTES;
constexpr int SEG_OFF = MISC_OFF + 256;
constexpr int IDXC_OFF = MISC_OFF + 1024;
constexpr int LDS_BYTES = 155648;
constexpr int IDXC_UNITS = (LDS_BYTES - IDXC_OFF) / 1024;

#define GAS __attribute__((address_space(1)))
#define LAS __attribute__((address_space(3)))
typedef unsigned short bf16;
typedef unsigned v4u __attribute__((ext_vector_type(4)));
typedef float f32x4 __attribute__((ext_vector_type(4)));
typedef GAS unsigned gu32;
#define RLX_AGENT __ATOMIC_RELAXED, __HIP_MEMORY_SCOPE_AGENT
#define LDS_WAIT() asm volatile("s_waitcnt lgkmcnt(0)" ::: "memory")
#define VM_WAIT() asm volatile("s_waitcnt vmcnt(0)" ::: "memory")
__device__ __forceinline__ unsigned f2bf(float f) { unsigned u = __builtin_bit_cast(unsigned, f); return (u + 0x7fffu + ((u >> 16) & 1u)) >> 16; }
__device__ __forceinline__ unsigned pk2(float lo, float hi) { return f2bf(lo) | (f2bf(hi) << 16); }
__device__ __forceinline__ float bf2f(unsigned short b) { return __builtin_bit_cast(float, (unsigned)b << 16); }
__device__ __forceinline__ float bflo(unsigned w) { return __builtin_bit_cast(float, w << 16); }
__device__ __forceinline__ float bfhi(unsigned w) { return __builtin_bit_cast(float, w & 0xffff0000u); }
__device__ __forceinline__ float log2gamma(int h) { return h == 0 ? -0.04580368961312479f : h == 1 ? -0.02272007650008353f : h == 2 ? -0.011315313227834146f : -0.005646563141142063f; }
__device__ __forceinline__ float sigmoidf_(float x) { return __builtin_amdgcn_rcpf(1.f + __builtin_amdgcn_exp2f(-1.4426950408889634f * x)); }
#define XB_TMO      128
#define XB_XCNT(j)  (256  + 64 * (j))
#define XB_XSUB(j)  (1280 + 64 * (j))
#define XB_XGEN(j)  (2304 + 64 * (j))
#define XB_TOP      3328
#define XB_TOPGEN   3392
#define XCD_BAR_WORDS 3456
#define XB_SPIN_CAP (1u << 18)

__device__ __forceinline__ unsigned xb_ld(unsigned* p)              { return __hip_atomic_load(p, __ATOMIC_RELAXED, __HIP_MEMORY_SCOPE_AGENT); }
__device__ __forceinline__ unsigned xb_add(unsigned* p, unsigned v) { return __hip_atomic_fetch_add(p, v, __ATOMIC_RELAXED, __HIP_MEMORY_SCOPE_AGENT); }
__device__ __forceinline__ unsigned xb_xcc_id() { return (unsigned)__builtin_amdgcn_s_getreg((3 << 11) | 20) & 0xFu; }
#define XB_SPIN(cond, bar) do { unsigned _sp = 0; while (cond) { __builtin_amdgcn_s_sleep(1); \
    if ((++_sp & 255u) == 0u) { if (xb_ld(&(bar)[XB_TMO])) break; if (_sp > XB_SPIN_CAP) { atomicAdd(&(bar)[XB_TMO], 1u); break; } } } } while (0)

struct XcdBarrier {
    unsigned* bar; unsigned x;
    volatile LAS unsigned* st;
};

__device__ __forceinline__ XcdBarrier xcd_barrier_post(unsigned* bar, volatile LAS unsigned* st) {
    XcdBarrier b; b.bar = bar; b.x = xb_xcc_id(); b.st = st;
    if (threadIdx.x == 0) (void)xb_add(&bar[XB_XCNT(b.x)], 1u);
    return b;
}
__device__ __forceinline__ void xcd_barrier_complete(unsigned* bar, unsigned x, unsigned& nloc, unsigned& nx) {
    const unsigned G = gridDim.x * gridDim.y * gridDim.z;
    unsigned sum, cnt, mine, sp = 0u;
    for (;;) {
        sum = 0u; cnt = 0u; mine = 0u;
#pragma unroll
        for (unsigned j = 0; j < 16; ++j) { const unsigned c = xb_ld(&bar[XB_XCNT(j)]); sum += c; cnt += (c > 0u) ? 1u : 0u; mine = (j == x) ? c : mine; }
        if (sum == G) break;
        __builtin_amdgcn_s_sleep(1);
        if ((++sp & 255u) == 0u) { if (xb_ld(&bar[XB_TMO])) break; if (sp > XB_SPIN_CAP) { atomicAdd(&bar[XB_TMO], 1u); break; } }
    }
    nloc = mine > 0u ? mine : 1u; nx = cnt > 0u ? cnt : 1u;
}

__device__ __forceinline__ void xcd_barrier(const XcdBarrier& b) {
    asm volatile("s_waitcnt vmcnt(0)" ::: "memory");
    __syncthreads();
    if (threadIdx.x == 0) {
        unsigned* bar = b.bar; asm volatile("" : "+s"(bar)); unsigned xq = b.x; asm volatile("" : "+s"(xq));
        __builtin_amdgcn_s_waitcnt(0);
        unsigned nloc = b.st[0], nx = b.st[1];
        if (nloc == 0u) { xcd_barrier_complete(bar, xq, nloc, nx); b.st[0] = nloc; b.st[1] = nx; }
        const unsigned old = xb_add(&bar[XB_XSUB(xq)], 1u);
        const unsigned gen = old / nloc;
        if (old + 1u == (gen + 1u) * nloc) {
            __builtin_amdgcn_fence(__ATOMIC_RELEASE, "agent");
            asm volatile("s_waitcnt vmcnt(0)" ::: "memory");
            const unsigned og = xb_add(&bar[XB_TOP], 1u);
            const unsigned tg = og / nx;
            if (og + 1u == (tg + 1u) * nx) xb_add(&bar[XB_TOPGEN], 1u);
            else XB_SPIN(xb_ld(&bar[XB_TOPGEN]) == tg, bar);
            __builtin_amdgcn_fence(__ATOMIC_ACQUIRE, "agent");
            xb_add(&bar[XB_XGEN(xq)], 1u);
            asm volatile("s_waitcnt vmcnt(0)" ::: "memory");
        } else {
            XB_SPIN(xb_ld(&bar[XB_XGEN(xq)]) == gen, bar);
            __builtin_amdgcn_fence(__ATOMIC_ACQUIRE, "agent");
            asm volatile("s_waitcnt vmcnt(0)" ::: "memory");
        }
    }
    __syncthreads();
}
#define ACC_T const pg8::f32x4 (&acc)[2][2][4][2]
#define FOR_AI_M _Pragma("unroll") for (int ai = 0; ai < 2; ++ai) _Pragma("unroll") for (int m = 0; m < 4; ++m)
__device__ __forceinline__ void sincos_rev(float turns, float& c, float& s) { const float t = __builtin_amdgcn_fractf(turns); c = __builtin_amdgcn_cosf(t); s = __builtin_amdgcn_sinf(t); }

struct EpiStore {
    bf16* O; int ldc;
    __device__ __forceinline__ void put(ACC_T, size_t row0, int col0, int wr, int wc, int fr, int fq, float sc) const {
        FOR_AI_M { bf16* rp = O + (row0 + 128 * ai + 64 * wr + 16 * m + fr) * (size_t)ldc + col0 + 32 * wc + 8 * fq;
#pragma unroll
            for (int bj = 0; bj < 2; ++bj) *(pg8::u32x4*)(rp + 128 * bj) = pg8::pack8(acc[ai][bj][m][0] * sc, acc[ai][bj][m][1] * sc); }
    }
};

struct EpiQK {
    bf16* QT; bf16* KT; bf16* PEX; bf16* KTT;
    __device__ __forceinline__ void operator()(ACC_T, const pg8::Unit& u, int wr, int wc, int fr, int fq) const {
        const bool isq = u.pn < 4; const int h = u.pn & 3; const float lg = log2gamma(h), gam = __builtin_amdgcn_exp2f(lg);
        float f2[2][4];
#pragma unroll
        for (int n = 0; n < 2; ++n)
#pragma unroll
            for (int i = 0; i < 4; ++i) f2[n][i] = __builtin_amdgcn_exp2f(-(float)(32 * wc + 8 * fq + 4 * n + i) * (L2THETA / 128.f)) * INV2PI;
        FOR_AI_M { const int s = u.pm * 256 + 128 * ai + 64 * wr + 16 * m + fr; const int cp = s & (RC - 1);
            const float dec = isq ? __builtin_amdgcn_exp2f((float)cp * lg) : __builtin_amdgcn_exp2f(-(float)cp * lg) * 0.0625f;
            pg8::f32x4 lo[2], hi[2];
#pragma unroll
            for (int n = 0; n < 2; ++n)
#pragma unroll
                for (int i = 0; i < 4; ++i) { float c, sn; sincos_rev((float)s * f2[n][i], c, sn); const float a = acc[ai][0][m][n][i], b = acc[ai][1][m][n][i];
                    lo[n][i] = (a * c - b * sn) * dec; hi[n][i] = (b * c + a * sn) * dec; }
            bf16* dst = (isq ? QT : KT) + (size_t)s * 1024 + h * 256 + 32 * wc + 8 * fq;
            *(pg8::u32x4*)dst = pg8::pack8(lo[0], lo[1]); *(pg8::u32x4*)(dst + 128) = pg8::pack8(hi[0], hi[1]);
            if (isq) { bf16* px = PEX + ((size_t)h * SEQ + s) * PXP + RC + 32 * wc + 8 * fq;
                *(pg8::u32x4*)px = pg8::pack8(lo[0] * gam, lo[1] * gam); *(pg8::u32x4*)(px + 128) = pg8::pack8(hi[0] * gam, hi[1] * gam); }
            else { bf16* tp = KTT + (size_t)(h * 256 + 32 * wc + 8 * fq) * SEQ + s;
#pragma unroll
                for (int n = 0; n < 2; ++n)
#pragma unroll
                    for (int i = 0; i < 4; ++i) { tp[(size_t)(4 * n + i) * SEQ] = (bf16)f2bf(lo[n][i]); tp[(size_t)(128 + 4 * n + i) * SEQ] = (bf16)f2bf(hi[n][i]); } } }
    }
};
struct EpiKVT {
    bf16* VTE;
    __device__ __forceinline__ void operator()(ACC_T, const pg8::Unit& u, int wr, int wc, int fr, int fq) const {
        const int row0 = u.pm * 256;
        FOR_AI_M { const int r = row0 + 128 * ai + 64 * wr + 16 * m + fr;
#pragma unroll
            for (int bj = 0; bj < 2; ++bj) { const int s0 = u.pn * 256 + 128 * bj + 32 * wc + 8 * fq;
                *(pg8::u32x4*)(VTE + (size_t)r * VTP + (s0 >> 9) * PXP + (s0 & (RC - 1))) = pg8::pack8(acc[ai][bj][m][0], acc[ai][bj][m][1]); } }
    }
};
struct EpiKV {
    bf16* VTE;
    __device__ __forceinline__ void operator()(ACC_T, const pg8::Unit& u, int wr, int wc, int fr, int fq) const {
        const int et = u.pm & 1, hn = u.pm >> 1, n = hn % NCH, h = hn / NCH; const float sc = __builtin_amdgcn_exp2f((float)(RC - 1) * log2gamma(h));
        EpiStore st{VTE, VTP}; st.put(acc, (size_t)(h * 512 + 256 * et), n * PXP + RC, wr, wc, fr, fq, sc);
    }
};
struct EpiP {
    bf16* PEX;
    __device__ __forceinline__ void operator()(ACC_T, const pg8::Unit& u, int wr, int wc, int fr, int fq) const {
        const int x = u.pm % 3, hn = u.pm / 3, n = hn % NCH, h = hn / NCH, it = x > 0 ? 1 : 0, jt = x > 1 ? 1 : 0; const bool diag = (x != 1);
        FOR_AI_M { const int r = 128 * ai + 64 * wr + 16 * m + fr; bf16* rp = PEX + ((size_t)h * SEQ + n * RC + 256 * it + r) * PXP + 256 * jt + 32 * wc + 8 * fq;
#pragma unroll
            for (int bj = 0; bj < 2; ++bj) { pg8::f32x4 v[2];
#pragma unroll
                for (int nn = 0; nn < 2; ++nn)
#pragma unroll
                    for (int i = 0; i < 4; ++i) { const int c = 128 * bj + 32 * wc + 8 * fq + 4 * nn + i; const bool keep = !diag || (c <= r); v[nn][i] = keep ? acc[ai][bj][m][nn][i] : 0.f; }
                *(pg8::u32x4*)(rp + 128 * bj) = pg8::pack8(v[0], v[1]);
                if (x == 0) *(pg8::u32x4*)(rp + 256 + 128 * bj) = (pg8::u32x4){0u, 0u, 0u, 0u}; } }
    }
};
struct EpiO {
    bf16* OG; float* SSP; int half;
    __device__ __forceinline__ void operator()(ACC_T, const pg8::Unit& u, int wr, int wc, int fr, int fq) const {
        const int it = u.pm & 1, hn = u.pm >> 1, n = hn % NCH, h = hn / NCH, et = u.pn;
        FOR_AI_M { const int s = n * RC + 256 * it + 128 * ai + 64 * wr + 16 * m + fr; bf16* rp = OG + ((size_t)half * SEQ + s) * 2048 + h * 512 + 256 * et + 32 * wc + 8 * fq;
            float ss = 0.f;
#pragma unroll
            for (int bj = 0; bj < 2; ++bj) { const pg8::f32x4 a = acc[ai][bj][m][0], b = acc[ai][bj][m][1];
                ss += (a[0] * a[0] + a[1] * a[1]) + (a[2] * a[2] + a[3] * a[3]) + (b[0] * b[0] + b[1] * b[1]) + (b[2] * b[2] + b[3] * b[3]);
                *(pg8::u32x4*)(rp + 128 * bj) = pg8::pack8(a, b); }
            ss += __shfl_xor(ss, 16); ss += __shfl_xor(ss, 32);
            if (fq == 0) SSP[((size_t)s * RH + h) * 8 + et * 4 + wc] = ss; }
    }
};
struct EpiGate {
    bf16* OG; const float* SSP; int half;
    __device__ __forceinline__ void operator()(ACC_T, const pg8::Unit& u, int wr, int wc, int fr, int fq) const {
        const int h = u.pn >> 1; float rs[2][4];
        FOR_AI_M { const int s = u.pm * 256 + 128 * ai + 64 * wr + 16 * m + fr; const f32x4 s0 = *(const f32x4*)(SSP + ((size_t)s * RH + h) * 8 + 4 * (fq & 1));
            float tot = (s0[0] + s0[1]) + (s0[2] + s0[3]); tot += __shfl_xor(tot, 16); rs[ai][m] = __builtin_amdgcn_rsqf(tot * (1.f / 512.f) + NORM_EPS); }
#pragma unroll
        for (int ai = 0; ai < 2; ++ai) { pg8::u32x4 ov[4][2];
#pragma unroll
            for (int m = 0; m < 4; ++m) { const bf16* rp = OG + ((size_t)half * SEQ + u.pm * 256 + 128 * ai + 64 * wr + 16 * m + fr) * 2048 + u.pn * 256 + 32 * wc + 8 * fq;
#pragma unroll
                for (int bj = 0; bj < 2; ++bj) ov[m][bj] = *(const pg8::u32x4*)(rp + 128 * bj); }
#pragma unroll
            for (int m = 0; m < 4; ++m) { bf16* rp = OG + ((size_t)half * SEQ + u.pm * 256 + 128 * ai + 64 * wr + 16 * m + fr) * 2048 + u.pn * 256 + 32 * wc + 8 * fq;
#pragma unroll
                for (int bj = 0; bj < 2; ++bj) { pg8::f32x4 v[2];
#pragma unroll
                    for (int nn = 0; nn < 2; ++nn)
#pragma unroll
                        for (int i = 0; i < 4; ++i) { const float gg = acc[ai][bj][m][nn][i]; const unsigned w = ov[m][bj][nn * 2 + (i >> 1)]; const float o = (i & 1) ? bfhi(w) : bflo(w);
                            v[nn][i] = gg * sigmoidf_(gg) * o * rs[ai][m]; }
                    *(pg8::u32x4*)(rp + 128 * bj) = pg8::pack8(v[0], v[1]); } } }
    }
};
__device__ __forceinline__ unsigned pk4_fp8(float a, float b, float c, float d) { int w = 0; w = __builtin_amdgcn_cvt_pk_fp8_f32(a, b, w, false); w = __builtin_amdgcn_cvt_pk_fp8_f32(c, d, w, true); return (unsigned)w; }
__device__ __forceinline__ unsigned pk4_i8(float a, float b, float c, float d) {
    const unsigned u0 = __builtin_bit_cast(unsigned, __builtin_amdgcn_fmed3f(a, -127.f, 127.f) + 12582912.f), u1 = __builtin_bit_cast(unsigned, __builtin_amdgcn_fmed3f(b, -127.f, 127.f) + 12582912.f);
    const unsigned u2 = __builtin_bit_cast(unsigned, __builtin_amdgcn_fmed3f(c, -127.f, 127.f) + 12582912.f), u3 = __builtin_bit_cast(unsigned, __builtin_amdgcn_fmed3f(d, -127.f, 127.f) + 12582912.f);
    return __builtin_amdgcn_perm(u1, u0, 0x0c0c0400u) | __builtin_amdgcn_perm(u3, u2, 0x04000c0cu); }
template <bool X8> struct EpiResT {
    const float* src; float* dst; bf16* XBo; float* SSQ;
    __device__ __forceinline__ void operator()(ACC_T, const pg8::Unit& u, int wr, int wc, int fr, int fq) const {
#pragma unroll
        for (int ai = 0; ai < 2; ++ai) { f32x4 xo[4][2][2];
#pragma unroll
            for (int m = 0; m < 4; ++m) { const size_t off = ((size_t)u.pm * 256 + 128 * ai + 64 * wr + 16 * m + fr) * DM + u.pn * 256 + 32 * wc + 8 * fq;
#pragma unroll
                for (int bj = 0; bj < 2; ++bj) { xo[m][bj][0] = *(const f32x4*)(src + off + 128 * bj); xo[m][bj][1] = *(const f32x4*)(src + off + 128 * bj + 4); } }
#pragma unroll
            for (int m = 0; m < 4; ++m) { const int row = u.pm * 256 + 128 * ai + 64 * wr + 16 * m + fr; const size_t off = (size_t)row * DM + u.pn * 256 + 32 * wc + 8 * fq; float ss = 0.f;
#pragma unroll
                for (int bj = 0; bj < 2; ++bj) { const f32x4 x0 = xo[m][bj][0] + acc[ai][bj][m][0], x1 = xo[m][bj][1] + acc[ai][bj][m][1];
                    *(f32x4*)(dst + off + 128 * bj) = x0; *(f32x4*)(dst + off + 128 * bj + 4) = x1;
                    if (XBo) { if constexpr (X8) *(unsigned long long*)((unsigned char*)XBo + off + 128 * bj) = (unsigned long long)pk4_i8(x0[0] * XSCI, x0[1] * XSCI, x0[2] * XSCI, x0[3] * XSCI) | ((unsigned long long)pk4_i8(x1[0] * XSCI, x1[1] * XSCI, x1[2] * XSCI, x1[3] * XSCI) << 32);
                        else *(pg8::u32x4*)(XBo + off + 128 * bj) = pg8::pack8(x0, x1);
                        ss += (x0[0] * x0[0] + x0[1] * x0[1]) + (x0[2] * x0[2] + x0[3] * x0[3]) + (x1[0] * x1[0] + x1[1] * x1[1]) + (x1[2] * x1[2] + x1[3] * x1[3]); } }
                if (XBo) { ss += __shfl_xor(ss, 16); ss += __shfl_xor(ss, 32); if (fq == 0) SSQ[(size_t)row * 16 + u.pn * 4 + wc] = ss; } } }
    }
};
typedef EpiResT<false> EpiRes; typedef EpiResT<true> EpiRes8;
__device__ __forceinline__ float row_rs(const float* SSQ, int row, int fq) { const f32x4 a = *(const f32x4*)(SSQ + (size_t)row * 16 + 4 * fq);
    float t = (a[0] + a[1]) + (a[2] + a[3]); t += __shfl_xor(t, 16); t += __shfl_xor(t, 32); return __builtin_amdgcn_rsqf(t * (1.f / DM) + NORM_EPS); }
struct EpiSwiGLU {
    bf16* ACT; int ldc; const float* SSQ;
    __device__ __forceinline__ void operator()(ACC_T, const pg8::Unit& u, int wr, int wc, int fr, int fq) const {
        float rsv[2][4];
        FOR_AI_M { const int row = u.pm * 256 + 128 * ai + 64 * wr + 16 * m + fr; rsv[ai][m] = SSQ ? row_rs(SSQ, row, fq) : 1.f; }
        FOR_AI_M { const int row = u.pm * 256 + 128 * ai + 64 * wr + 16 * m + fr; const float rs = rsv[ai][m];
            bf16* rp = ACT + (size_t)row * ldc + u.pn * 128 + 32 * wc + 8 * fq; pg8::f32x4 v[2];
#pragma unroll
            for (int nn = 0; nn < 2; ++nn)
#pragma unroll
                for (int i = 0; i < 4; ++i) { const float gg = acc[ai][0][m][nn][i] * rs; v[nn][i] = gg * sigmoidf_(gg) * (acc[ai][1][m][nn][i] * rs); }
            *(pg8::u32x4*)rp = pg8::pack8(v[0], v[1]); }
    }
};
template <bool I8O> struct EpiSwiGLU8T {
    unsigned char* ACT; int ldc; float osc; const float* SSQ;
    __device__ __forceinline__ void operator()(ACC_T, const pg8::Unit& u, int wr, int wc, int fr, int fq) const {
        float rsv[2][4];
        FOR_AI_M { const int row = u.pm * 256 + 128 * ai + 64 * wr + 16 * m + fr; rsv[ai][m] = SSQ ? row_rs(SSQ, row, fq) : 1.f; }
        FOR_AI_M { const int row = u.pm * 256 + 128 * ai + 64 * wr + 16 * m + fr; const float rs = rsv[ai][m], rso = rs * osc;
            unsigned char* rp = ACT + (size_t)row * ldc + u.pn * 128 + 32 * wc + 8 * fq; pg8::f32x4 v[2];
#pragma unroll
            for (int nn = 0; nn < 2; ++nn)
#pragma unroll
                for (int i = 0; i < 4; ++i) { const float gg = acc[ai][0][m][nn][i] * rs; v[nn][i] = gg * sigmoidf_(gg) * (acc[ai][1][m][nn][i] * rso); }
            if constexpr (I8O) *(unsigned long long*)rp = (unsigned long long)pk4_i8(v[0][0], v[0][1], v[0][2], v[0][3]) | ((unsigned long long)pk4_i8(v[1][0], v[1][1], v[1][2], v[1][3]) << 32);
            else *(unsigned long long*)rp = (unsigned long long)pk4_fp8(v[0][0], v[0][1], v[0][2], v[0][3]) | ((unsigned long long)pk4_fp8(v[1][0], v[1][1], v[1][2], v[1][3]) << 32); }
    }
};
typedef EpiSwiGLU8T<false> EpiSwiGLU8;
struct EpiSwiGLUI {
    unsigned char* ACT; int ldc; float osc; const float* SSQ; float qs;
    __device__ __forceinline__ void operator()(ACC_T, const pg8::Unit& u, int wr, int wc, int fr, int fq) const {
        float rsv[2][4];
        FOR_AI_M { const int row = u.pm * 256 + 128 * ai + 64 * wr + 16 * m + fr; rsv[ai][m] = (SSQ ? row_rs(SSQ, row, fq) : 1.f) * qs; }
        FOR_AI_M { const int row = u.pm * 256 + 128 * ai + 64 * wr + 16 * m + fr; const float rs = rsv[ai][m], c1 = -1.4426950408889634f * rs, c2 = rs * rs * osc * (256.f / 32767.f);
            unsigned char* rp = ACT + (size_t)row * ldc + u.pn * 128 + 32 * wc + 8 * fq; float v[2][4];
#pragma unroll
            for (int nn = 0; nn < 2; ++nn)
#pragma unroll
                for (int i = 0; i < 4; ++i) { const float ga = acc[ai][0][m][nn][i], ua = acc[ai][1][m][nn][i]; const float g0 = (float)__builtin_bit_cast(int, ga), u0 = (float)__builtin_bit_cast(int, ua);
                    const float r = __builtin_amdgcn_rcpf(1.f + __builtin_amdgcn_exp2f(g0 * c1)); v[nn][i] = __builtin_fmaf((g0 * u0) * r, c2, 128.f / 32767.f); }
            unsigned w[2];
#pragma unroll
            for (int nn = 0; nn < 2; ++nn) { const unsigned d0 = __builtin_bit_cast(unsigned, __builtin_amdgcn_cvt_pknorm_i16(v[nn][0], v[nn][1])), d1 = __builtin_bit_cast(unsigned, __builtin_amdgcn_cvt_pknorm_i16(v[nn][2], v[nn][3]));
                w[nn] = __builtin_amdgcn_perm(d1, d0, 0x07050301u); }
            *(unsigned long long*)rp = (unsigned long long)w[0] | ((unsigned long long)w[1] << 32); }
    }
};
namespace pg8 { template <> struct epi_raw_i32<EpiSwiGLUI> { static constexpr bool value = true; }; }
struct EpiKVQ {
    bf16* K; bf16* V; bf16* Q; const float* SSQ; unsigned* NRM;
    __device__ __forceinline__ void operator()(ACC_T, const pg8::Unit& u, int wr, int wc, int fr, int fq) const {
        if (u.pn >= 4 && u.pn < 8) {
            float rsv[2][4];
            FOR_AI_M { rsv[ai][m] = row_rs(SSQ, u.pm * 256 + 128 * ai + 64 * wr + 16 * m + fr, fq); }
            FOR_AI_M { const int row = u.pm * 256 + 128 * ai + 64 * wr + 16 * m + fr; const float rs = rsv[ai][m]; bf16* rp = V + (size_t)row * 1024 + (u.pn - 4) * 256 + 32 * wc + 8 * fq;
#pragma unroll
                for (int bj = 0; bj < 2; ++bj) *(pg8::u32x4*)(rp + 128 * bj) = pg8::pack8(acc[ai][bj][m][0] * rs, acc[ai][bj][m][1] * rs); }
            return; }
        const bool isq = u.pn >= 8; const int ct = isq ? u.pn - 8 : u.pn; const float sc = isq ? C2Q : 1.f;
        float f2[2][4];
#pragma unroll
        for (int n = 0; n < 2; ++n)
#pragma unroll
            for (int i = 0; i < 4; ++i) f2[n][i] = __builtin_amdgcn_exp2f(-(float)(8 * fq + 4 * n + i) * (L2THETA / 32.f)) * INV2PI;
        float nmx = 0.f; float rsv[2][4];
        FOR_AI_M { rsv[ai][m] = row_rs(SSQ, u.pm * 256 + 128 * ai + 64 * wr + 16 * m + fr, fq); }
        FOR_AI_M { const int row = u.pm * 256 + 128 * ai + 64 * wr + 16 * m + fr; const int s = row & (SEQ - 1); const float rsc = rsv[ai][m] * sc;
            pg8::f32x4 lo[2], hi[2]; float ss = 0.f;
#pragma unroll
            for (int n = 0; n < 2; ++n)
#pragma unroll
                for (int i = 0; i < 4; ++i) { float c, sn; sincos_rev((float)s * f2[n][i], c, sn); const float a = acc[ai][0][m][n][i], b = acc[ai][1][m][n][i];
                    lo[n][i] = (a * c - b * sn) * rsc; hi[n][i] = (b * c + a * sn) * rsc; ss += lo[n][i] * lo[n][i] + hi[n][i] * hi[n][i]; }
            ss += __shfl_xor(ss, 16); ss += __shfl_xor(ss, 32); nmx = fmaxf(nmx, ss);
            bf16* dst = (isq ? Q : K) + (size_t)row * 1024 + ct * 256 + 64 * wc + 8 * fq;
            *(pg8::u32x4*)dst = pg8::pack8(lo[0], lo[1]); *(pg8::u32x4*)(dst + 32) = pg8::pack8(hi[0], hi[1]); }
        nmx = fmaxf(nmx, __shfl_xor(nmx, 1)); nmx = fmaxf(nmx, __shfl_xor(nmx, 2)); nmx = fmaxf(nmx, __shfl_xor(nmx, 4)); nmx = fmaxf(nmx, __shfl_xor(nmx, 8));
        nmx *= 1.02f;
        if (fr == 0 && fq == 0) (void)__hip_atomic_fetch_max(NRM + ((isq ? 2 : 0) + (u.pm * 256) / SEQ) * 16 + ct * 4 + wc, __builtin_bit_cast(unsigned, nmx), __ATOMIC_RELAXED, __HIP_MEMORY_SCOPE_AGENT);
    }
};
struct EpiMoeDown {
    bf16* Y; const float* slot_w; float wscale;
    __device__ __forceinline__ void operator()(ACC_T, const pg8::Unit& u, int wr, int wc, int fr, int fq) const {
        float wv[2][4];
        FOR_AI_M { wv[ai][m] = slot_w[u.pm * 256 + 128 * ai + 64 * wr + 16 * m + fr] * wscale; }
        FOR_AI_M { const float w = wv[ai][m]; bf16* rp = Y + (size_t)(u.pm * 256 + 128 * ai + 64 * wr + 16 * m + fr) * DM + u.pn * 256 + 32 * wc + 8 * fq;
#pragma unroll
            for (int bj = 0; bj < 2; ++bj) *(pg8::u32x4*)(rp + 128 * bj) = pg8::pack8(acc[ai][bj][m][0] * w, acc[ai][bj][m][1] * w); }
    }
};
struct EpiPart {
    bf16* PART;
    __device__ __forceinline__ void operator()(ACC_T, const pg8::Unit& u, int wr, int wc, int fr, int fq) const { EpiStore st{PART, 256}; st.put(acc, (size_t)u.pm * 256, 0, wr, wc, fr, fq, 1.f); }
};

struct SchedPlain {
    pg8::TileOrder ord; const char* A; const char* B; size_t sa, sb;
    __device__ __forceinline__ bool next(int i, pg8::Unit& u) const { int pm, pn; if (!ord.tile(i, pm, pn)) return false; u.pm = pm; u.pn = pn; u.a = A + pm * sa; u.b = B + pn * sb; return true; }
};
struct SchedKV {
    pg8::TileOrder ord; const char* VTE; const char* KTT;
    __device__ __forceinline__ bool next(int i, pg8::Unit& u) const { int pm, pn; if (!ord.tile(i, pm, pn)) return false; u.pm = pm; u.pn = pn; const int x = pm & 1, hn = pm >> 1, n = hn % NCH, h = hn / NCH;
        u.a = VTE + ((size_t)(h * 512 + 256 * x) * VTP + n * PXP) * 2; u.b = KTT + ((size_t)(h * 256) * SEQ + n * RC) * 2; return true; }
};
struct SchedP {
    pg8::TileOrder ord; const char* QT; const char* KT;
    __device__ __forceinline__ bool next(int i, pg8::Unit& u) const { int pm, pn; if (!ord.tile(i, pm, pn)) return false; u.pm = pm; u.pn = pn; const int x = pm % 3, hn = pm / 3, n = hn % NCH, h = hn / NCH, it = x > 0 ? 1 : 0, jt = x > 1 ? 1 : 0;
        u.a = QT + ((size_t)(n * RC + 256 * it) * 1024 + h * 256) * 2; u.b = KT + ((size_t)(n * RC + 256 * jt) * 1024 + h * 256) * 2; return true; }
};
struct SchedO {
    pg8::TileOrder ord; const char* PEX; const char* VTE;
    __device__ __forceinline__ bool next(int i, pg8::Unit& u) const { int pm, pn; if (!ord.tile(i, pm, pn)) return false; u.pm = pm; u.pn = pn; const int it = pm & 1, hn = pm >> 1, n = hn % NCH, h = hn / NCH;
        u.a = PEX + ((size_t)h * SEQ + n * RC + 256 * it) * PXP * 2; u.b = VTE + ((size_t)(h * 512 + 256 * pn) * VTP + n * PXP) * 2; return true; }
};
struct SchedMoe {
    pg8::TileOrder ord; const char* A; const char* B; size_t sa, sb, se; const LAS int* seg; int lim;
    __device__ __forceinline__ int expert(int pm) const { int e = 0;
#pragma unroll
        for (int j = 1; j < NE; ++j) e += (pm >= seg[j]) ? 1 : 0;
        return __builtin_amdgcn_readfirstlane(e); }
    __device__ __forceinline__ bool next(int i, pg8::Unit& u) const { const long L = (long)i * ord.G + ord.c; if (L >= lim) return false; int pm, pn; ord.tileL((int)L, pm, pn); u.pm = pm; u.pn = pn;
        u.a = A + pm * sa; u.b = B + expert(pm) * se + pn * sb; return true; }
};
struct SchedMoeSplit {
    pg8::TileOrder ord; const char* A; const char* B; size_t sa, sb, se; const LAS int* seg; int first, nparts, s; size_t kb;
    __device__ __forceinline__ bool next(int i, pg8::Unit& u) const { const long J = (long)i * ord.G + ord.c; if (J >= nparts) return false; const int j = (int)J, un = first + j / s, part = j % s; int pm, pn; ord.tileL(un, pm, pn); u.pm = pm; u.pn = pn;
        int e = 0;
#pragma unroll
        for (int q = 1; q < NE; ++q) e += (pm >= seg[q]) ? 1 : 0;
        e = __builtin_amdgcn_readfirstlane(e);
        u.a = A + pm * sa + part * kb; u.b = B + e * se + pn * sb + part * kb; u.pm = j; return true; }
};
__device__ __forceinline__ float wave_sum(float v) {
#pragma unroll
    for (int o = 1; o < 64; o <<= 1) v += __shfl_xor(v, o);
    return v;
}
struct RmOff { int off; __device__ __forceinline__ int operator()(int n) const { return off + n; } };
struct RmGU { int up; __device__ __forceinline__ int operator()(int n) const { return 256 * (n >> 7) + 128 * up + (n & 127); } };
struct RmRope { int off; __device__ __forceinline__ int operator()(int n) const { const int w = n & 255; return off + (n & ~255) + 128 * ((w >> 5) & 1) + 32 * (w >> 6) + (w & 31); } };
template <class RM, bool I8 = false>
__device__ __forceinline__ void transpose_item(const float* W, int K, int N, bf16* WT, const float* gain, const RM rm, LAS float* scr, int item, int lane, float sc8 = 1.f) {
    const int nblk = N / 32, kb = item / nblk, nb = item % nblk, k0 = 64 * kb, n0 = 32 * nb;
    const int n4 = lane & 7, kr = lane >> 3;
    f32x4 v[8]; float gv[8];
#pragma unroll
    for (int j = 0; j < 8; ++j) v[j] = *(const GAS f32x4*)(W + (size_t)(k0 + 8 * j + kr) * N + n0 + 4 * n4);
#pragma unroll
    for (int j = 0; j < 8; ++j) gv[j] = gain ? gain[k0 + 8 * j + kr] : 1.f;
#pragma unroll
    for (int j = 0; j < 8; ++j) { LAS float* d = scr + (8 * j + kr) * 33 + 4 * n4; d[0] = v[j].x * gv[j]; d[1] = v[j].y * gv[j]; d[2] = v[j].z * gv[j]; d[3] = v[j].w * gv[j]; }
    LDS_WAIT(); asm volatile("" ::: "memory");
    const int c = lane & 7;
#pragma unroll
    for (int j = 0; j < 4; ++j) { const int n = (lane >> 3) + 8 * j; const LAS float* s = scr + (8 * c) * 33 + n;
        if constexpr (I8) *(GAS unsigned long long*)((unsigned char*)WT + (size_t)rm(n0 + n) * K + k0 + 8 * c) = (unsigned long long)pk4_i8(s[0 * 33] * sc8, s[1 * 33] * sc8, s[2 * 33] * sc8, s[3 * 33] * sc8) | ((unsigned long long)pk4_i8(s[4 * 33] * sc8, s[5 * 33] * sc8, s[6 * 33] * sc8, s[7 * 33] * sc8) << 32);
        else { v4u o; o.x = pk2(s[0 * 33], s[1 * 33]); o.y = pk2(s[2 * 33], s[3 * 33]); o.z = pk2(s[4 * 33], s[5 * 33]); o.w = pk2(s[6 * 33], s[7 * 33]);
            *(GAS v4u*)(WT + (size_t)rm(n0 + n) * K + k0 + 8 * c) = o; } }
    LDS_WAIT(); asm volatile("" ::: "memory");
}
struct TItem { const float* W; unsigned char* WT; const float* gain; int K, N, up, item; float sc; };
__device__ __forceinline__ void ti_load(const TItem& t, int lane, f32x4 (&v)[8], float (&gv)[8]) {
    const int nblk = t.N / 32, kb = t.item / nblk, nb = t.item % nblk, k0 = 64 * kb, n0 = 32 * nb, n4 = lane & 7, kr = lane >> 3;
#pragma unroll
    for (int j = 0; j < 8; ++j) v[j] = *(const GAS f32x4*)(t.W + (size_t)(k0 + 8 * j + kr) * t.N + n0 + 4 * n4);
#pragma unroll
    for (int j = 0; j < 8; ++j) gv[j] = t.gain ? t.gain[k0 + 8 * j + kr] : 1.f;
}
__device__ __forceinline__ void ti_store(const TItem& t, int lane, const f32x4 (&v)[8], const float (&gv)[8], LAS float* scr) {
    const int nblk = t.N / 32, kb = t.item / nblk, nb = t.item % nblk, k0 = 64 * kb, n0 = 32 * nb, n4 = lane & 7, kr = lane >> 3;
#pragma unroll
    for (int j = 0; j < 8; ++j) { LAS float* d = scr + (8 * j + kr) * 33 + 4 * n4; d[0] = v[j].x * gv[j]; d[1] = v[j].y * gv[j]; d[2] = v[j].z * gv[j]; d[3] = v[j].w * gv[j]; }
    LDS_WAIT(); asm volatile("" ::: "memory");
    const int c = lane & 7;
#pragma unroll
    for (int j = 0; j < 4; ++j) { const int n = n0 + (lane >> 3) + 8 * j; const LAS float* s = scr + (8 * c) * 33 + (lane >> 3) + 8 * j; const int row = t.up < 0 ? n : 256 * (n >> 7) + 128 * t.up + (n & 127);
        const float sc = t.sc;
        const float f0 = s[0 * 33] * sc, f1 = s[1 * 33] * sc, f2 = s[2 * 33] * sc, f3 = s[3 * 33] * sc, f4 = s[4 * 33] * sc, f5 = s[5 * 33] * sc, f6 = s[6 * 33] * sc, f7 = s[7 * 33] * sc;
        *(GAS unsigned long long*)(t.WT + (size_t)row * t.K + k0 + 8 * c) = (unsigned long long)pk4_i8(f0, f1, f2, f3) | ((unsigned long long)pk4_i8(f4, f5, f6, f7) << 32); }
    LDS_WAIT(); asm volatile("" ::: "memory");
}
__device__ __forceinline__ float rms_row_to_bf16(const float* xrow, bf16* orow, int lane, f32x4 (&v)[4]) {
    const GAS f32x4* xr = (const GAS f32x4*)xrow + lane; float s = 0.f;
#pragma unroll
    for (int j = 0; j < 4; ++j) { v[j] = xr[64 * j]; s += (v[j].x * v[j].x + v[j].y * v[j].y) + (v[j].z * v[j].z + v[j].w * v[j].w); }
    const float rs = __builtin_amdgcn_rsqf(wave_sum(s) * (1.f / DM) + NORM_EPS);
    GAS unsigned long long* o8 = (GAS unsigned long long*)orow + lane;
#pragma unroll
    for (int j = 0; j < 4; ++j) o8[64 * j] = (unsigned long long)pk2(v[j].x * rs, v[j].y * rs) | ((unsigned long long)pk2(v[j].z * rs, v[j].w * rs) << 32);
    return rs;
}

__device__ __forceinline__ void moe_split(int nmt, int G, int& U, int& full, int& rem, int& sp) {
    U = nmt * 4; full = (U / G) * G; rem = U - full; sp = 1;
    if (rem > 0) sp = (rem * 14 <= G) ? 14 : (rem * 7 <= G) ? 7 : (rem * 2 <= G) ? 2 : 1;
}
__device__ __forceinline__ void moe_reduce(const bf16* PART, bf16* Y, const int* slot_tok, const float* slot_w, int nmt, int G, int gw, int NGW, int lane, float wscale) {
    int U, full, rem, sp; moe_split(nmt, G, U, full, rem, sp);
    if (sp <= 1) return;
    pg8::TileOrder ord; ord.init(nmt, 4, G, 0);
    for (int it = gw; it < rem * 256; it += NGW) { const int ui = it >> 8, r = it & 255; int pm, pn; ord.tileL(full + ui, pm, pn);
        const int slot = pm * 256 + r, tok = slot_tok[slot]; if (tok < 0) continue;
        float a0 = 0.f, a1 = 0.f, a2 = 0.f, a3 = 0.f; unsigned long long pv[14];
#pragma unroll
        for (int p = 0; p < 14; ++p) pv[p] = *(const GAS unsigned long long*)(PART + ((size_t)(ui * sp + (p < sp ? p : sp - 1)) * 256 + r) * 256 + 4 * lane);
#pragma unroll
        for (int p = 0; p < 14; ++p) if (p < sp) { const unsigned long long v = pv[p];
            a0 += bflo((unsigned)v); a1 += bfhi((unsigned)v); a2 += bflo((unsigned)(v >> 32)); a3 += bfhi((unsigned)(v >> 32)); }
        const float w = slot_w[slot] * wscale; *((GAS unsigned long long*)(Y + (size_t)slot * DM + pn * 256) + lane) = (unsigned long long)pk2(a0 * w, a1 * w) | ((unsigned long long)pk2(a2 * w, a3 * w) << 32); }
}

__device__ __forceinline__ void route_row(const f32x4 (&v)[4], int m, int t0, int lane, unsigned char* XB8, const float (&wr)[16][NE], LAS int* es, unsigned char* ws) {
    float s = 0.f;
#pragma unroll
    for (int j = 0; j < 4; ++j) s += (v[j].x * v[j].x + v[j].y * v[j].y) + (v[j].z * v[j].z + v[j].w * v[j].w);
    const float rs = __builtin_amdgcn_rsqf(wave_sum(s) * (1.f / DM) + NORM_EPS);
    GAS unsigned* o4 = (GAS unsigned*)(XB8 + (size_t)m * DM) + lane; const float r8 = rs * XSCI;
#pragma unroll
    for (int j = 0; j < 4; ++j) o4[64 * j] = pk4_i8(v[j].x * r8, v[j].y * r8, v[j].z * r8, v[j].w * r8);
    float lg[NE];
#pragma unroll
    for (int e = 0; e < NE; ++e) lg[e] = 0.f;
#pragma unroll
    for (int j = 0; j < 4; ++j)
#pragma unroll
        for (int i = 0; i < 4; ++i) { const float xv = v[j][i];
#pragma unroll
            for (int e = 0; e < NE; ++e) lg[e] += xv * wr[4 * j + i][e]; }
#pragma unroll
    for (int e = 0; e < NE; ++e) lg[e] = wave_sum(lg[e]) * rs;
    int e0 = 0; float m0 = lg[0];
#pragma unroll
    for (int e = 1; e < NE; ++e) if (lg[e] > m0) { m0 = lg[e]; e0 = e; }
    int e1 = -1; float m1 = 0.f;
#pragma unroll
    for (int e = 0; e < NE; ++e) if (e != e0 && (e1 < 0 || lg[e] > m1)) { m1 = lg[e]; e1 = e; }
    const float w1v = 1.f / (1.f + __expf(m0 - m1)), w0v = 1.f - w1v;
    if (lane == 0) { ((int*)(ws + WS_TOKE))[m] = e0 | (e1 << 8); ((float*)(ws + WS_TOKW))[2 * m] = w0v; ((float*)(ws + WS_TOKW))[2 * m + 1] = w1v; es[2 * (m - t0)] = e0; es[2 * (m - t0) + 1] = e1; }
}

enum { IN_X = 0, IN_ANG, IN_FNG, IN_RWIN, IN_RWOUT, IN_KVNG, IN_WKV, IN_WQ, IN_LQ1, IN_LK1, IN_LQ2, IN_LK2, IN_SUBG, IN_WO, IN_FG, IN_FU, IN_FD, IN_MR, IN_MG, IN_MU, IN_MD, IN_FING, N_IN };
struct Args { const float* in[N_IN]; float* out; unsigned char* ws; int ph_lo, ph_hi; };
constexpr int N_PHASES = 24;
#ifndef ALIGN_E
#define ALIGN_E true
#endif
#ifndef REP_MASK
#define REP_MASK 0u
#endif
#define REPC(c) (1 + (int)(((REP_MASK) >> (c)) & 1u))

__global__ void __launch_bounds__(NWAVES * 64, 2) yoco_fwd(Args args) {
    extern __shared__ __attribute__((aligned(16))) unsigned char lds[];
    LAS unsigned char* L = (LAS unsigned char*)lds;
    volatile LAS unsigned* MISC = (volatile LAS unsigned*)(L + MISC_OFF);
    LAS int* SEG = (LAS int*)(L + SEG_OFF);
    LAS int* IDXC = (LAS int*)(L + IDXC_OFF);
    const int tid0 = threadIdx.x, wave = __builtin_amdgcn_readfirstlane(tid0 >> 6);
#define FRESH_TID int tid = threadIdx.x; asm volatile("" : "+v"(tid)); const int lane = tid & 63; (void)lane
    const int G = gridDim.x, bx = blockIdx.x; const int vcu = (G % 8 == 0) ? (bx % 8) * (G / 8) + bx / 8 : bx;
    unsigned char* ws = args.ws;
    gu32* ctl = (gu32*)(ws + WS_CTL);
    float* const X = args.out;
    for (int u = tid0; u < (IDXC_OFF - MISC_OFF) / 4; u += NWAVES * 64) ((LAS unsigned*)(L + MISC_OFF))[u] = 0u;
    __syncthreads();
    XcdBarrier bar = xcd_barrier_post((unsigned*)(ctl + CW_BAR), MISC + 8);
    const int lo = args.ph_lo, hi = args.ph_hi;
#ifndef PH_MASK
#define PH_MASK 0xffffffffu
#endif
#define CLS(c) (((PH_MASK) >> (c)) & 1u)
#define IN(k) (lo <= (k) && (k) < hi)
#define SEAM(k) do { if (IN(k) && IN((k) + 1)) xcd_barrier(bar); } while (0)
    const int gw = vcu * NWAVES + wave, NGW = G * NWAVES;
    bf16* const XB = (bf16*)(ws + WS_XB);

    if (CLS(0) && IN(0)) for (int rep_ = 0; rep_ < REPC(0); ++rep_) { FRESH_TID;
        LAS float* scr = (LAS float*)(L + RING_OFF + wave * 16384);
        const float* g0 = args.in[IN_ANG]; const float* g1 = args.in[IN_ANG] + DM; const float* f0 = args.in[IN_FNG];
        constexpr int I_WIN = 16 * 192, I_WOUT = 32 * 32, I_G = 16 * 88, I_D = 44 * 32, I_KV = 16 * 64, I_Q = 16 * 32, I_O = 16 * 32;
        constexpr int NIT = I_WIN + I_WOUT + 2 * I_G + I_D + I_KV + I_Q + I_O;
        int it = gw;
        for (int m = gw; m < TOK || it < NIT; m += 2 * NGW) { const bool hr = m < TOK; const int mm = hr ? m : 0;
            const int m2 = mm + NGW; const bool has2 = hr && m2 < TOK; const float* xin = args.in[IN_X];
            const GAS f32x4* xa = (const GAS f32x4*)(xin + (size_t)mm * DM) + lane; const GAS f32x4* xb = (const GAS f32x4*)(xin + (size_t)(has2 ? m2 : mm) * DM) + lane; f32x4 va[4], vb[4]; float sa = 0.f, sb = 0.f;
#pragma unroll
            for (int j = 0; j < 4; ++j) va[j] = xa[64 * j];
#pragma unroll
            for (int j = 0; j < 4; ++j) vb[j] = xb[64 * j];
            if (it < NIT) { do {
            int r = it;
            if (r < I_WIN) {
                if (r % 192 < 64) transpose_item(args.in[IN_RWIN], 1024, 6144, (bf16*)(ws + WS_WIN), g0, RmOff{0}, scr, r, lane);
                else transpose_item<RmOff, true>(args.in[IN_RWIN], 1024, 6144, (bf16*)(ws + WS_WIN + 4 * MiB), g0, RmOff{-2048}, scr, r, lane, WSCI);
                break; } r -= I_WIN;
            if (r < I_WOUT) { transpose_item(args.in[IN_RWOUT], 2048, 1024, (bf16*)(ws + WS_WOUT), (const float*)nullptr, RmOff{0}, scr, r, lane); break; } r -= I_WOUT;
            if (r < I_G) { transpose_item<RmGU, true>(args.in[IN_FG], 1024, DFF, (bf16*)(ws + WS_WGU), f0, RmGU{0}, scr, r, lane, WSCI); break; } r -= I_G;
            if (r < I_G) { transpose_item<RmGU, true>(args.in[IN_FU], 1024, DFF, (bf16*)(ws + WS_WGU), f0, RmGU{1}, scr, r, lane, WSCI); break; } r -= I_G;
            if (r < I_D) { transpose_item<RmOff, true>(args.in[IN_FD], DFF, 1024, (bf16*)(ws + WS_WD), (const float*)nullptr, RmOff{0}, scr, r, lane, WDSCI_D); break; } r -= I_D;
            if (r < I_KV) {
                const int nblk = 64, nb = r % nblk;
                if (nb < 32) transpose_item<RmRope, true>(args.in[IN_WKV], 1024, 2048, (bf16*)(ws + WS_WKVQ), args.in[IN_KVNG], RmRope{0}, scr, r, lane, WSCI);
                else transpose_item<RmOff, true>(args.in[IN_WKV], 1024, 2048, (bf16*)(ws + WS_WKVQ), args.in[IN_KVNG], RmOff{0}, scr, r, lane, WSCI);
                break; } r -= I_KV;
            if (r < I_Q) { transpose_item<RmRope, true>(args.in[IN_WQ], 1024, 1024, (bf16*)(ws + WS_WKVQ), g1, RmRope{2048}, scr, r, lane, WSCI); break; } r -= I_Q;
            transpose_item<RmOff, true>(args.in[IN_WO], 1024, 1024, (bf16*)(ws + WS_WO), (const float*)nullptr, RmOff{0}, scr, r, lane, WOSCI);
                    } while (0); it += NGW; }
            if (!hr) continue;
#pragma unroll
            for (int j = 0; j < 4; ++j) { sa += (va[j].x * va[j].x + va[j].y * va[j].y) + (va[j].z * va[j].z + va[j].w * va[j].w); sb += (vb[j].x * vb[j].x + vb[j].y * vb[j].y) + (vb[j].z * vb[j].z + vb[j].w * vb[j].w); }
            const float ra = __builtin_amdgcn_rsqf(wave_sum(sa) * (1.f / DM) + NORM_EPS), rb = __builtin_amdgcn_rsqf(wave_sum(sb) * (1.f / DM) + NORM_EPS);
            GAS unsigned long long* oa = (GAS unsigned long long*)(XB + (size_t)mm * DM) + lane; GAS unsigned long long* ob = (GAS unsigned long long*)(XB + (size_t)(has2 ? m2 : mm) * DM) + lane;
            GAS unsigned* ia = (GAS unsigned*)((unsigned char*)X + (size_t)mm * DM) + lane; GAS unsigned* ib = (GAS unsigned*)((unsigned char*)X + (size_t)(has2 ? m2 : mm) * DM) + lane;
#pragma unroll
            for (int j = 0; j < 4; ++j) { oa[64 * j] = (unsigned long long)pk2(va[j].x * ra, va[j].y * ra) | ((unsigned long long)pk2(va[j].z * ra, va[j].w * ra) << 32); const float ri = ra * XSCI; ia[64 * j] = pk4_i8(va[j].x * ri, va[j].y * ri, va[j].z * ri, va[j].w * ri); }
            if (has2) {
#pragma unroll
                for (int j = 0; j < 4; ++j) { ob[64 * j] = (unsigned long long)pk2(vb[j].x * rb, vb[j].y * rb) | ((unsigned long long)pk2(vb[j].z * rb, vb[j].w * rb) << 32); const float ri = rb * XSCI; ib[64 * j] = pk4_i8(vb[j].x * ri, vb[j].y * ri, vb[j].z * ri, vb[j].w * ri); } } }
    }
    SEAM(0);

    for (int hh = 0; hh < 3; ++hh) {
        const int p0 = 1 + 4 * hh;
        bf16* const QT = (bf16*)(ws + WS_QT); bf16* const KT = (bf16*)(ws + WS_KT); bf16* const KTT = (bf16*)(ws + WS_KTT); bf16* const VTE = (bf16*)(ws + WS_VTE); bf16* const PEX = (bf16*)(ws + WS_PEX);
        bf16* const OG = (bf16*)(ws + WS_OG); float* const SSP = (float*)(ws + WS_SSP);
        if (CLS(6) && IN(p0) && hh > 0) {
            const int half = hh - 1; const char* xih = (const char*)X + (size_t)half * SEQ * DM;
            SchedPlain S; S.ord.init(SEQ / 256, 8, G, bx); S.A = xih; S.B = (const char*)(ws + WS_WIN + 4 * MiB) + (size_t)2048 * DM; S.sa = (size_t)256 * DM; S.sb = (size_t)256 * DM;
            EpiGate E{OG, SSP, half};
            pg8::gemm_phase<EpiGate, SchedPlain, ALIGN_E, false, false, true>(L + RING_OFF, pg8::Shape{DM / 2, DM / 2, DM / 128, 0, 0, 1.f / (XSCI * WSCI)}, S, E);
        }
        const int half = hh;
        const char* xbh = (const char*)(XB + (size_t)half * SEQ * DM);
        if (CLS(1) && IN(p0) && hh < 2) for (int rep_ = 0; rep_ < REPC(1); ++rep_) {
            {
                SchedPlain S; S.ord.init(SEQ / 256, 8, G, bx); S.A = xbh; S.B = (const char*)(ws + WS_WIN); S.sa = (size_t)256 * DM * 2; S.sb = (size_t)256 * DM * 2;
                EpiQK E{QT, KT, PEX, KTT};
                pg8::gemm_phase<EpiQK, SchedPlain, ALIGN_E, false>(L + RING_OFF, pg8::Shape{DM, DM, DM / 64}, S, E);
            }
            {
                SchedPlain S; S.ord.init(8, SEQ / 256, G, bx); S.A = (const char*)(ws + WS_WIN + 4 * MiB); S.B = (const char*)X + (size_t)half * SEQ * DM; S.sa = (size_t)256 * DM; S.sb = (size_t)256 * DM;
                EpiKVT E{VTE};
                pg8::gemm_phase<EpiKVT, SchedPlain, ALIGN_E, false, false, true>(L + RING_OFF, pg8::Shape{DM / 2, DM / 2, DM / 128, 0, 0, 1.f / (XSCI * WSCI)}, S, E);
            }
        }
        SEAM(p0);
        if (hh == 2) break;
        if (CLS(2) && IN(p0 + 1)) for (int rep_ = 0; rep_ < REPC(2); ++rep_) {
            SchedKV S; S.ord.init(RH * NCH * 2, 1, G, bx); S.VTE = (const char*)VTE; S.KTT = (const char*)KTT;
            EpiKV E{VTE};
            pg8::gemm_phase<EpiKV, SchedKV, ALIGN_E, false>(L + RING_OFF, pg8::Shape{VTP, SEQ, RC / 64}, S, E);
        }
        if (CLS(4) && IN(p0 + 1)) for (int rep_ = 0; rep_ < REPC(4); ++rep_) {
            SchedP S; S.ord.init(RH * NCH * 3, 1, G, bx); S.QT = (const char*)QT; S.KT = (const char*)KT;
            EpiP E{PEX};
            pg8::gemm_phase<EpiP, SchedP, ALIGN_E, false>(L + RING_OFF, pg8::Shape{DM, DM, 256 / 64}, S, E);
        }
        SEAM(p0 + 1);
        if (CLS(3) && IN(p0 + 2)) { FRESH_TID;
            const int gt = vcu * (NWAVES * 64) + tid, NGT = G * NWAVES * 64;
            for (int w = gt; w < RH * 512 * 64; w += NGT) {
                const int d4 = w & 63, e = (w >> 6) & 511, h = w >> 15; const float gC = __builtin_amdgcn_exp2f((float)RC * log2gamma(h));
                bf16* p = VTE + (size_t)(h * 512 + e) * VTP + RC + 4 * d4;
                float r0 = 0.f, r1 = 0.f, r2 = 0.f, r3 = 0.f;
                for (int n0 = 0; n0 < NCH; n0 += 16) {
                    unsigned long long t[16];
#pragma unroll
                    for (int j = 0; j < 16; ++j) t[j] = *(const GAS unsigned long long*)(p + (size_t)(n0 + j) * PXP);
#pragma unroll
                    for (int j = 0; j < 16; ++j) { *(GAS unsigned long long*)(p + (size_t)(n0 + j) * PXP) = (unsigned long long)pk2(r0, r1) | ((unsigned long long)pk2(r2, r3) << 32);
                        const unsigned lo = (unsigned)t[j], hi = (unsigned)(t[j] >> 32);
                        r0 = r0 * gC + bflo(lo); r1 = r1 * gC + bfhi(lo); r2 = r2 * gC + bflo(hi); r3 = r3 * gC + bfhi(hi); }
                }
            }
        }
        SEAM(p0 + 2);
        if (CLS(5) && IN(p0 + 3)) for (int rep_ = 0; rep_ < REPC(5); ++rep_) {
            SchedO S; S.ord.init(RH * NCH * 2, 2, G, bx); S.PEX = (const char*)PEX; S.VTE = (const char*)VTE;
            EpiO E{OG, SSP, half};
            pg8::gemm_phase<EpiO, SchedO, ALIGN_E, false>(L + RING_OFF, pg8::Shape{PXP, VTP, PXP / 64}, S, E);
        }
        SEAM(p0 + 3);
    }

    if (CLS(7) && IN(10)) for (int rep_ = 0; rep_ < REPC(7); ++rep_) {
        SchedPlain S; S.ord.init(TOK / 256, 4, G, bx); S.A = (const char*)(ws + WS_OG); S.B = (const char*)(ws + WS_WOUT); S.sa = (size_t)256 * 2048 * 2; S.sb = (size_t)256 * 2048 * 2;
        EpiRes8 E{args.in[IN_X], X, XB, (float*)(ws + WS_SSP)};
        pg8::gemm_phase<EpiRes8, SchedPlain, ALIGN_E, false>(L + RING_OFF, pg8::Shape{2048, 2048, 2048 / 64}, S, E);
    }
    SEAM(10);
    if (CLS(9) && IN(11)) for (int rep_ = 0; rep_ < REPC(9); ++rep_) {
        SchedPlain S; S.ord.init(TOK / 256, DFF / 128, G, bx); S.A = (const char*)XB; S.B = (const char*)(ws + WS_WGU); S.sa = (size_t)256 * DM; S.sb = (size_t)256 * DM;
        EpiSwiGLUI E{ws + WS_ACT, DFF, ASCI, (const float*)(ws + WS_SSP), 1.f / (XSCI * WSCI)};
        pg8::gemm_phase<EpiSwiGLUI, SchedPlain, ALIGN_E, false, false, true>(L + RING_OFF, pg8::Shape{DM / 2, DM / 2, DM / 128, 0, 0, 1.f / (XSCI * WSCI)}, S, E);
    }
    SEAM(11);
    if (CLS(10) && IN(12)) {
        SchedPlain S; S.ord.init(TOK / 256, 4, G, bx); S.A = (const char*)(ws + WS_ACT); S.B = (const char*)(ws + WS_WD); S.sa = (size_t)256 * DFF; S.sb = (size_t)256 * DFF;
        EpiRes8 E{X, X, XB, (float*)(ws + WS_SSP)};
        pg8::gemm_phase<EpiRes8, SchedPlain, ALIGN_E, false, false, true>(L + RING_OFF, pg8::Shape{DFF / 2, DFF / 2, DFF / 128, 0, 0, 1.f / (ASCI * WDSCI_D)}, S, E);
    }
    SEAM(12);
    if (CLS(12) && IN(13)) for (int rep_ = 0; rep_ < REPC(12); ++rep_) {
        SchedPlain S; S.ord.init(TOK / 256, 12, G, bx); S.A = (const char*)XB; S.B = (const char*)(ws + WS_WKVQ); S.sa = (size_t)256 * DM; S.sb = (size_t)256 * DM;
        EpiKVQ E{(bf16*)(ws + WS_K), (bf16*)(ws + WS_V), (bf16*)(ws + WS_Q), (const float*)(ws + WS_SSP), (unsigned*)(ctl + CW_NRM)};
        pg8::gemm_phase<EpiKVQ, SchedPlain, ALIGN_E, false, false, true>(L + RING_OFF, pg8::Shape{DM / 2, DM / 2, DM / 128, 0, 0, 1.f / (XSCI * WSCI)}, S, E);
    }
    SEAM(13);
    if (CLS(13) && IN(14)) {
        float lam; { const int ln_ = threadIdx.x & 63; const float l1 = args.in[IN_LQ1][ln_] * args.in[IN_LK1][ln_], l2 = args.in[IN_LQ2][ln_] * args.in[IN_LK2][ln_]; lam = __expf(wave_sum(l1)) - __expf(wave_sum(l2)) + LAMBDA_INIT; }
        for (int rep_ = 0; rep_ < REPC(13); ++rep_)
        attn_body::attn_phase<8>((char*)lds + RING_OFF, (const attn_body::bf16*)(ws + WS_Q), (const attn_body::bf16*)(ws + WS_K), (const attn_body::bf16*)(ws + WS_V),
                                 (attn_body::bf16*)(ws + WS_O0), (attn_body::bf16*)(ws + WS_O1), (attn_body::bf16*)(ws + WS_OB8), (const unsigned*)(ctl + CW_NRM), lam, args.in[IN_SUBG], (1.f - LAMBDA_INIT) * OSCI, SUBLN_EPS, vcu, G);
    }
    SEAM(14);
    if (CLS(15) && IN(15)) {
        SchedPlain S; S.ord.init(TOK / 256, 4, G, bx); S.A = (const char*)(ws + WS_OB8); S.B = (const char*)(ws + WS_WO); S.sa = (size_t)256 * DM; S.sb = (size_t)256 * DM;
        EpiRes E{X, X, (bf16*)nullptr, (float*)nullptr};
        pg8::gemm_phase<EpiRes, SchedPlain, ALIGN_E, false, false, true>(L + RING_OFF, pg8::Shape{DM / 2, DM / 2, DM / 128, 0, 0, 1.f / (OSCI * WOSCI)}, S, E);
    }
    SEAM(15);
    const int TPB = (TOK + G - 1) / G;
    if (CLS(16) && IN(16)) for (int rep_ = 0; rep_ < REPC(16); ++rep_) { FRESH_TID;
        LAS int* es = (LAS int*)(L + RING_OFF + 12288);
        LAS int* rk = es + 512;
        const float* f1 = args.in[IN_FNG] + DM;
        float wr[16][NE];
#pragma unroll
        for (int j = 0; j < 4; ++j)
#pragma unroll
            for (int i = 0; i < 4; ++i) { const int kk = 256 * j + 4 * lane + i; const GAS f32x4* wp = (const GAS f32x4*)(args.in[IN_MR] + (size_t)kk * NE); const f32x4 w0 = wp[0], w1 = wp[1]; const float gk = f1[kk];
                wr[4 * j + i][0] = w0[0] * gk; wr[4 * j + i][1] = w0[1] * gk; wr[4 * j + i][2] = w0[2] * gk; wr[4 * j + i][3] = w0[3] * gk; wr[4 * j + i][4] = w1[0] * gk; wr[4 * j + i][5] = w1[1] * gk; wr[4 * j + i][6] = w1[2] * gk; wr[4 * j + i][7] = w1[3] * gk; }
        __syncthreads();
        const int t0 = bx * TPB, t1 = (t0 + TPB < TOK) ? t0 + TPB : TOK;
        LAS float* scr = (LAS float*)(L + RING_OFF + wave * 16384);
        constexpr int I_E = 16 * 112, NIT_ = NE * 3 * I_E;
#define MOE_ITEM(t_, it_) do { const int e_ = (it_) / (3 * I_E), r_ = (it_) % (3 * I_E), wh_ = r_ / I_E; (t_).item = r_ % I_E; \
                if (wh_ < 2) { (t_).W = (wh_ ? args.in[IN_MU] : args.in[IN_MG]) + (size_t)e_ * 1024 * DFE; (t_).WT = (ws + WS_WMGU) + (size_t)e_ * 7168 * 1024; (t_).gain = f1; (t_).K = 1024; (t_).N = DFE; (t_).up = wh_; (t_).sc = WSCI; } \
                else { (t_).W = args.in[IN_MD] + (size_t)e_ * DFE * 1024; (t_).WT = (ws + WS_WMD) + (size_t)e_ * 1024 * DFE; (t_).gain = nullptr; (t_).K = DFE; (t_).N = 1024; (t_).up = -1; (t_).sc = WDSCI_M; } } while (0)
        int it = gw;
        for (int m = t0 + wave; m < t1; m += 2 * NWAVES) {
            const int m2 = m + NWAVES; const bool has2 = m2 < t1;
            f32x4 va[4], vb[4];
            { const GAS f32x4* xa = (const GAS f32x4*)(X + (size_t)m * DM) + lane; const GAS f32x4* xb = (const GAS f32x4*)(X + (size_t)(has2 ? m2 : m) * DM) + lane;
#pragma unroll
              for (int j = 0; j < 4; ++j) va[j] = xa[64 * j];
#pragma unroll
              for (int j = 0; j < 4; ++j) vb[j] = xb[64 * j]; }
            for (int c = 0; c < 2 && it < NIT_; ++c, it += NGW) { TItem tc; f32x4 vc[8]; float gc[8]; MOE_ITEM(tc, it); ti_load(tc, lane, vc, gc); ti_store(tc, lane, vc, gc, scr); }
            route_row(va, m, t0, lane, (unsigned char*)XB, wr, es, ws);
            if (has2) route_row(vb, m2, t0, lane, (unsigned char*)XB, wr, es, ws);
        }
        __syncthreads();
        if (wave == 0) {
            int cnt[2][NE];
#pragma unroll
            for (int k = 0; k < 2; ++k)
#pragma unroll
                for (int e = 0; e < NE; ++e) cnt[k][e] = 0;
            const int nt_ = t1 - t0;
            for (int r0 = 0; r0 < nt_; r0 += 64) { const int li = r0 + lane; const bool ok = li < nt_;
#pragma unroll
                for (int k = 0; k < 2; ++k) { const int ek = ok ? es[2 * li + k] : -1; int myr = 0;
#pragma unroll
                    for (int e = 0; e < NE; ++e) { const unsigned long long mk = __ballot(ek == e); if (ek == e) myr = cnt[k][e] + __popcll(mk & ((1ull << lane) - 1ull)); cnt[k][e] += __popcll(mk); }
                    if (ok) rk[2 * li + k] = myr; } }
            LDS_WAIT();
            for (int li = lane; li < nt_; li += 64) ((int*)(ws + WS_TOKR))[t0 + li] = rk[2 * li] | (rk[2 * li + 1] << 16);
            if (lane < 16) { int c = 0;
#pragma unroll
                for (int k = 0; k < 2; ++k)
#pragma unroll
                    for (int e = 0; e < NE; ++e) if (lane == k * NE + e) c = cnt[k][e];
                ((int*)(ws + WS_HIST))[bx * 16 + lane] = c; }
        }
        if (it < NIT_) { TItem ta; f32x4 va[8]; float ga[8]; MOE_ITEM(ta, it); ti_load(ta, lane, va, ga);
            for (;;) { const int nit = it + NGW; TItem tb = ta; f32x4 vb[8]; float gb[8];
                if (nit < NIT_) { MOE_ITEM(tb, nit); ti_load(tb, lane, vb, gb); }
                ti_store(ta, lane, va, ga, scr);
                if (nit >= NIT_) break;
                ta = tb; it = nit;
#pragma unroll
                for (int j = 0; j < 8; ++j) { va[j] = vb[j]; ga[j] = gb[j]; } } }
#undef MOE_ITEM
    }
    SEAM(16);
    if (IN(17) || IN(18) || IN(19) || IN(20) || IN(21) || IN(22)) { FRESH_TID;
        LAS int* tot = (LAS int*)(L + RING_OFF);
        if (tid < 32) tot[tid] = 0;
        __syncthreads();
        { const int c = tid & 15; int t = 0, mine = 0; const int* hist = (const int*)(ws + WS_HIST);
#pragma unroll
            for (int j = 0; j < 8; ++j) { const int b = (tid >> 4) + 32 * j; if (b < G) { const int v = hist[b * 16 + c]; if (b < bx) mine += v; t += v; } }
            for (int b = (tid >> 4) + 256; b < G; b += 32) { const int v = hist[b * 16 + c]; if (b < bx) mine += v; t += v; }
            atomicAdd((int*)&tot[c], t); atomicAdd((int*)&tot[16 + c], mine); }
        __syncthreads();
        if (tid < 2) { int acc_ = 0; for (int e = 0; e < NE; ++e) { SEG[tid * 12 + e] = acc_; acc_ += (tot[tid * NE + e] + 255) >> 8; } SEG[tid * 12 + NE] = acc_; }
        __syncthreads();
    }
    if (CLS(17) && IN(17)) { FRESH_TID;
        LAS int* tot = (LAS int*)(L + RING_OFF);
        int* slot_tok = (int*)(ws + WS_SLOTT); float* slot_w = (float*)(ws + WS_SLOTW);
        const int t0 = bx * TPB, t1 = (t0 + TPB < TOK) ? t0 + TPB : TOK;
        for (int m = t0 + tid; m < t1; m += NWAVES * 64) { const int ee = ((const int*)(ws + WS_TOKE))[m], rr = ((const int*)(ws + WS_TOKR))[m];
#pragma unroll
            for (int k = 0; k < 2; ++k) { const int e = (ee >> (8 * k)) & 255, r = (rr >> (16 * k)) & 0xffff; const int slot = SEG[k * 12 + e] * 256 + tot[16 + k * NE + e] + r;
                slot_tok[k * SLOTS + slot] = m; slot_w[k * SLOTS + slot] = ((const float*)(ws + WS_TOKW))[2 * m + k]; ((int*)(ws + WS_TOKS))[2 * m + k] = slot; } }
        if (bx < 16) { const int k = bx >> 3, e = bx & 7; const int beg = SEG[k * 12 + e] * 256 + tot[k * NE + e], end = SEG[k * 12 + e + 1] * 256;
            for (int s = beg + tid; s < end; s += NWAVES * 64) { slot_tok[k * SLOTS + s] = -1; slot_w[k * SLOTS + s] = 0.f; } }
        if (G < 16 && bx == 0) { for (int ke = G; ke < 16; ++ke) { const int k = ke >> 3, e = ke & 7; const int beg = SEG[k * 12 + e] * 256 + tot[k * NE + e], end = SEG[k * 12 + e + 1] * 256;
            for (int s = beg + tid; s < end; s += NWAVES * 64) { slot_tok[k * SLOTS + s] = -1; slot_w[k * SLOTS + s] = 0.f; } } }
        __syncthreads();
    }
    SEAM(17);
    for (int k = 0; k < 2; ++k) {
        const int pg = 18 + 2 * k;
        const int* slot_tok = (const int*)(ws + WS_SLOTT) + k * SLOTS; const float* slot_w = (const float*)(ws + WS_SLOTW) + k * SLOTS;
        const int nmt = __builtin_amdgcn_readfirstlane(SEG[k * 12 + NE]);
        if (CLS(18) && IN(pg)) for (int rep_ = 0; rep_ < REPC(18); ++rep_) { FRESH_TID;
            if (k == 1 && rep_ == 0) moe_reduce((const bf16*)(ws + WS_PART), (bf16*)(ws + WS_Y), (const int*)(ws + WS_SLOTT), (const float*)(ws + WS_SLOTW), __builtin_amdgcn_readfirstlane(SEG[NE]), G, gw, NGW, lane, 1.f);
            SchedMoe S; S.ord.init(nmt, DFE / 128, G, bx); S.A = (const char*)XB; S.B = (const char*)(ws + WS_WMGU); S.sa = 0; S.sb = (size_t)256 * DM; S.se = (size_t)7168 * DM; S.seg = SEG + k * 12; S.lim = S.ord.nwg;
            {
                pg8::Unit u;
                for (int i = wave; i < IDXC_UNITS && S.next(i, u); i += NWAVES) { const int* sp = slot_tok + u.pm * 256 + lane; int t[4];
#pragma unroll
                    for (int j = 0; j < 4; ++j) t[j] = sp[64 * j];
#pragma unroll
                    for (int j = 0; j < 4; ++j) IDXC[i * 256 + 64 * j + lane] = t[j] < 0 ? 0 : t[j]; }
                __syncthreads();
            }
            EpiSwiGLUI E{ws + WS_ACTM, DFE, ASCI, (const float*)nullptr, 1.f / (XSCI * WSCI)};
            pg8::gemm_phase<EpiSwiGLUI, SchedMoe, ALIGN_E, true, false, true>(L + RING_OFF, pg8::Shape{DM / 2, DM / 2, DM / 128, 0, 0, 1.f / (XSCI * WSCI)}, S, E, IDXC);
        }
        SEAM(pg);
        if (CLS(19) && IN(pg + 1)) for (int rep_ = 0; rep_ < REPC(19); ++rep_) {
            int U, full, rem, sp; moe_split(nmt, G, U, full, rem, sp);
            const float wsc = (rep_ + 1 < REPC(19)) ? 0.f : 1.f;
            {
                SchedMoe S; S.ord.init(nmt, 4, G, bx); S.A = (const char*)(ws + WS_ACTM); S.B = (const char*)(ws + WS_WMD); S.sa = (size_t)256 * DFE; S.sb = (size_t)256 * DFE; S.se = (size_t)1024 * DFE; S.seg = SEG + k * 12;
                S.lim = (sp > 1) ? full : U;
                EpiMoeDown E{(bf16*)(ws + WS_Y) + (size_t)k * SLOTS * DM, slot_w, wsc};
                pg8::gemm_phase<EpiMoeDown, SchedMoe, ALIGN_E, false, false, true>(L + RING_OFF, pg8::Shape{DFE / 2, DFE / 2, DFE / 128, 0, 0, 1.f / (ASCI * WDSCI_M)}, S, E);
            }
            if (sp > 1) {
                SchedMoeSplit S; S.ord.init(nmt, 4, G, bx); S.A = (const char*)(ws + WS_ACTM); S.B = (const char*)(ws + WS_WMD); S.sa = (size_t)256 * DFE; S.sb = (size_t)256 * DFE; S.se = (size_t)1024 * DFE; S.seg = SEG + k * 12;
                S.first = full; S.nparts = rem * sp; S.s = sp; S.kb = (size_t)(DFE / sp);
                EpiPart E{(bf16*)(ws + WS_PART)};
                pg8::gemm_phase<EpiPart, SchedMoeSplit, ALIGN_E, false, false, true>(L + RING_OFF, pg8::Shape{DFE / 2, DFE / 2, (DFE / 128) / sp, 0, 0, 1.f / (ASCI * WDSCI_M)}, S, E);
            }
        }
        SEAM(pg + 1);
    }
    if (CLS(19) && IN(22)) { FRESH_TID; moe_reduce((const bf16*)(ws + WS_PART), (bf16*)(ws + WS_Y) + (size_t)SLOTS * DM, (const int*)(ws + WS_SLOTT) + SLOTS, (const float*)(ws + WS_SLOTW) + SLOTS, __builtin_amdgcn_readfirstlane(SEG[12 + NE]), G, gw, NGW, lane, 1.f); }
    SEAM(22);
    if (CLS(20) && IN(23)) { FRESH_TID;
        const bool poison = __hip_atomic_load((gu32*)(ctl + CW_BAR + XB_TMO), RLX_AGENT) != 0u;
        const GAS f32x4* gp = (const GAS f32x4*)args.in[IN_FING] + lane; f32x4 gg[4];
#pragma unroll
        for (int j = 0; j < 4; ++j) gg[j] = gp[64 * j];
        const int* toks = (const int*)(ws + WS_TOKS);
        int nsa0 = 0, nsa1 = 0, nsb0 = 0, nsb1 = 0;
        if (gw < TOK) { const int mb0 = (gw + NGW < TOK) ? gw + NGW : gw; nsa0 = toks[2 * gw]; nsa1 = toks[2 * gw + 1]; nsb0 = toks[2 * mb0]; nsb1 = toks[2 * mb0 + 1]; }
        for (int m = gw; m < TOK; m += 2 * NGW) {
            const int m2 = m + NGW; const bool has2 = m2 < TOK;
            GAS f32x4* xa = (GAS f32x4*)(X + (size_t)m * DM) + lane; GAS f32x4* xb = (GAS f32x4*)(X + (size_t)(has2 ? m2 : m) * DM) + lane; f32x4 va[4], vb[4]; float sa = 0.f, sb = 0.f;
#pragma unroll
            for (int j = 0; j < 4; ++j) va[j] = xa[64 * j];
#pragma unroll
            for (int j = 0; j < 4; ++j) vb[j] = xb[64 * j];
            {
                const bf16* Y0 = (const bf16*)(ws + WS_Y); const bf16* Y1 = Y0 + (size_t)SLOTS * DM;
                const int sa0 = __builtin_amdgcn_readfirstlane(nsa0), sa1 = __builtin_amdgcn_readfirstlane(nsa1), sb0 = __builtin_amdgcn_readfirstlane(nsb0), sb1 = __builtin_amdgcn_readfirstlane(nsb1);
                { const int mn = m + 2 * NGW; if (mn < TOK) { const int mnb = (mn + NGW < TOK) ? mn + NGW : mn; nsa0 = toks[2 * mn]; nsa1 = toks[2 * mn + 1]; nsb0 = toks[2 * mnb]; nsb1 = toks[2 * mnb + 1]; } }
                const GAS unsigned long long* ya0 = (const GAS unsigned long long*)(Y0 + (size_t)sa0 * DM) + lane; const GAS unsigned long long* ya1 = (const GAS unsigned long long*)(Y1 + (size_t)sa1 * DM) + lane;
                const GAS unsigned long long* yb0 = (const GAS unsigned long long*)(Y0 + (size_t)sb0 * DM) + lane; const GAS unsigned long long* yb1 = (const GAS unsigned long long*)(Y1 + (size_t)sb1 * DM) + lane;
                unsigned long long qa0[4], qa1[4], qb0[4], qb1[4];
#pragma unroll
                for (int j = 0; j < 4; ++j) { qa0[j] = ya0[64 * j]; qa1[j] = ya1[64 * j]; qb0[j] = yb0[64 * j]; qb1[j] = yb1[64 * j]; }
#pragma unroll
                for (int j = 0; j < 4; ++j) {
                    va[j].x += bflo((unsigned)qa0[j]) + bflo((unsigned)qa1[j]); va[j].y += bfhi((unsigned)qa0[j]) + bfhi((unsigned)qa1[j]); va[j].z += bflo((unsigned)(qa0[j] >> 32)) + bflo((unsigned)(qa1[j] >> 32)); va[j].w += bfhi((unsigned)(qa0[j] >> 32)) + bfhi((unsigned)(qa1[j] >> 32));
                    vb[j].x += bflo((unsigned)qb0[j]) + bflo((unsigned)qb1[j]); vb[j].y += bfhi((unsigned)qb0[j]) + bfhi((unsigned)qb1[j]); vb[j].z += bflo((unsigned)(qb0[j] >> 32)) + bflo((unsigned)(qb1[j] >> 32)); vb[j].w += bfhi((unsigned)(qb0[j] >> 32)) + bfhi((unsigned)(qb1[j] >> 32)); } }
#pragma unroll
            for (int j = 0; j < 4; ++j) { sa += (va[j].x * va[j].x + va[j].y * va[j].y) + (va[j].z * va[j].z + va[j].w * va[j].w); sb += (vb[j].x * vb[j].x + vb[j].y * vb[j].y) + (vb[j].z * vb[j].z + vb[j].w * vb[j].w); }
            float ra = __builtin_amdgcn_rsqf(wave_sum(sa) * (1.f / DM) + NORM_EPS), rb = __builtin_amdgcn_rsqf(wave_sum(sb) * (1.f / DM) + NORM_EPS); if (poison) { ra = __builtin_nanf(""); rb = ra; }
#pragma unroll
            for (int j = 0; j < 4; ++j) xa[64 * j] = va[j] * ra * gg[j];
            if (has2) {
#pragma unroll
                for (int j = 0; j < 4; ++j) xb[64 * j] = vb[j] * rb * gg[j]; } }
    }
#undef IN
#undef FRESH_TID
#undef CLS
#undef SEAM
}

extern "C" void kernel_launch(void* const* d_in, const int* in_sizes, int n_in, void* d_out, int out_size, void* d_ws, size_t ws_size, hipStream_t stream) {
    static int grid = 0;
    if (grid == 0) {
        if (n_in != N_IN || in_sizes[0] != TOK * DM || out_size != TOK * DM || ws_size < WS_END) { fprintf(stderr, "kernel_launch: unexpected problem shape or workspace (%d inputs, ws %zu); nothing launched\n", n_in, ws_size); grid = -1; return; }
        int dev = 0, cus = 0, per_cu = 0;
        if (hipGetDevice(&dev) != hipSuccess || hipDeviceGetAttribute(&cus, hipDeviceAttributeMultiprocessorCount, dev) != hipSuccess) { grid = -1; return; }
        if (hipFuncSetAttribute((const void*)yoco_fwd, hipFuncAttributeMaxDynamicSharedMemorySize, LDS_BYTES) != hipSuccess) { fprintf(stderr, "kernel_launch: hipFuncSetAttribute failed\n"); grid = -1; return; }
        if (hipOccupancyMaxActiveBlocksPerMultiprocessor(&per_cu, (const void*)yoco_fwd, NWAVES * 64, LDS_BYTES) != hipSuccess || per_cu < 1) { fprintf(stderr, "kernel_launch: occupancy query reports %d workgroups per CU\n", per_cu); }
        (void)hipGetLastError();
        grid = cus;
        if (grid < 128 || grid > 1024 || (MAXMT * (DFE / 128) + grid - 1) / grid > IDXC_UNITS) { fprintf(stderr, "kernel_launch: unsupported CU count %d\n", cus); grid = -1; return; }
    }
    if (grid < 0) return;
    if (hipMemsetAsync((char*)d_ws + WS_CTL, 0, CTL_ZERO_BYTES, stream) != hipSuccess) return;
    Args a{};
    for (int i = 0; i < N_IN; ++i) a.in[i] = (const float*)d_in[i];
    a.out = (float*)d_out; a.ws = (unsigned char*)d_ws; a.ph_lo = 0; a.ph_hi = N_PHASES;
    hipLaunchKernelGGL(yoco_fwd, dim3(grid), dim3(NWAVES * 64), LDS_BYTES, stream, a);
}
```

```cpp
#include <hip/hip_runtime.h>
#include <hip/hip_bf16.h>
#include <cstdio>
#include <cstdint>
#include <cmath>

#ifndef WGM_SET
#define WGM_SET 6
#endif
namespace pg8 {
#define PG8_LAS __attribute__((address_space(3)))
typedef unsigned short bf16_t;
typedef short bf16x8 __attribute__((ext_vector_type(8)));
typedef float f32x4 __attribute__((ext_vector_type(4)));
typedef unsigned u32x4 __attribute__((ext_vector_type(4)));
typedef int i32x4 __attribute__((ext_vector_type(4)));
typedef int i32x8 __attribute__((ext_vector_type(8)));
constexpr int BM = 256, BK = 64, HALF = 128, HTB = HALF * BK * 2  , STAGE_BYTES = 8 * HTB, NXCD = 8, WGM = WGM_SET;

__host__ __device__ __forceinline__ int lds_byte(int r, int c) { const int st = (r >> 4) * 2 + (c >> 5), rr = r & 15, cc = c & 31, ob = rr * 64 + cc * 2; return st * 1024 + (ob ^ (((ob >> 9) & 1) << 5)); }
__host__ __device__ __forceinline__ void stage_rc(int b, int& R, int& C) { const int st = b / 1024, sb = b % 1024, swz = sb ^ (((sb >> 9) & 1) << 5); R = (st >> 1) * 16 + swz / 64; C = (st & 1) * 32 + (swz % 64) / 2; }
__host__ __device__ __forceinline__ int perm32(int rho) { const int n = rho >> 4, i = rho & 15; return 8 * (i >> 2) + 4 * n + (i & 3); }

struct Unit { const char* a; const char* b; int pm, pn; };
struct Shape { int lda, ldb, nt; int sclb = 0x7f7f7f7f, scla = 0x7f7f7f7f; float qscale = 1.f; };

struct TileOrder {
    int nM, nN, nwg, G, c, wgm;
    __device__ __forceinline__ void init(int nM_, int nN_, int G_, int c_, int wgm_ = WGM) { nM = nM_; nN = nN_; nwg = nM * nN; G = G_; c = c_; wgm = wgm_; }
    __device__ __forceinline__ bool tile(int i, int& pm, int& pn) const { const long L = (long)i * G + c; if (L >= nwg) return false; tileL((int)L, pm, pn); return true; }
    __device__ __forceinline__ void tileL(int L, int& pm, int& pn) const {
        int wgid = L; { const int q = nwg / NXCD, r = nwg % NXCD, xcd = wgid % NXCD, off = wgid / NXCD; wgid = (xcd < r ? xcd * (q + 1) : r * (q + 1) + (xcd - r) * q) + off; }
        const int nig = wgm * nN, gid = wgid / nig, fm = gid * wgm, gsz = (nM - fm) < wgm ? (nM - fm) : wgm;
        pm = fm + ((wgid % nig) % gsz); pn = (wgid % nig) / gsz;
    }
};

typedef float f32x2_t __attribute__((ext_vector_type(2))); typedef __bf16 bf16x2_t __attribute__((ext_vector_type(2)));
__device__ __forceinline__ unsigned cvt_pk_bf16(float lo, float hi) { f32x2_t v = {lo, hi}; bf16x2_t b = __builtin_convertvector(v, bf16x2_t); return __builtin_bit_cast(unsigned, b); }
__device__ __forceinline__ u32x4 pack8(const f32x4 v0, const f32x4 v1) { u32x4 w; w.x = cvt_pk_bf16(v0[0], v0[1]); w.y = cvt_pk_bf16(v0[2], v0[3]); w.z = cvt_pk_bf16(v1[0], v1[1]); w.w = cvt_pk_bf16(v1[2], v1[3]); return w; }

template <class E> struct epi_raw_i32 { static constexpr bool value = false; };
template <class Epi, class Sched, bool ALIGN_EPI, bool GATHER, bool F8 = false, bool I8 = false>
__device__ __forceinline__ void gemm_phase(PG8_LAS unsigned char* lds, const Shape g, const Sched& S, const Epi& E, const PG8_LAS unsigned short* idxc = nullptr) {
    int tid = threadIdx.x; asm volatile("" : "+v"(tid));
    const int wid = __builtin_amdgcn_readfirstlane(tid >> 6), lane = tid & 63, wr = wid >> 2, wc = wid & 3, fr = lane & 15, fq = lane >> 4;
    int nt = __builtin_amdgcn_readfirstlane(g.nt); asm volatile("" : "+s"(nt));
    int RA[2], CA[2];
    unsigned vB[2], vA[2], vAc[2][2], vAn[2][2];
#pragma unroll
    for (int i = 0; i < 2; ++i) { int R, C; stage_rc(tid * 16 + i * 8192, R, C); const int Rb = (R & ~31) + perm32(R & 31); RA[i] = R; CA[i] = C;
        vB[i] = (unsigned)(Rb * g.ldb + C) * 2u; vA[i] = (unsigned)(R * g.lda + C) * 2u;
#pragma unroll
        for (int h = 0; h < 2; ++h) { vAc[h][i] = 0u; vAn[h][i] = 0u; } }
    const size_t hsA = GATHER ? (size_t)0 : (size_t)HALF * g.lda * 2, hsB = (size_t)HALF * g.ldb * 2;
    const size_t kstep = (size_t)(BK * 2);
    const unsigned ldsw = (unsigned)wid * 1024u;
    const int aoff = lds_byte(wr * 64 + fr, fq * 8), boff = lds_byte(wc * 32 + fr, fq * 8);
#define PG8_SA(b, h) (((b) * 2 + (h)) * HTB)
#define PG8_SB(b, h) ((4 + (b) * 2 + (h)) * HTB)
#define PG8_STAGE(bufoff, gbase, voff) do { _Pragma("unroll") for (int _i = 0; _i < 2; ++_i) \
        __builtin_amdgcn_global_load_lds((const unsigned*)((const char*)(gbase) + (voff)[_i]), (PG8_LAS unsigned*)(lds + (bufoff) + ldsw + _i * 8192), 16, 0, 0); } while (0)
#define PG8_STB(b, h, gbase) PG8_STAGE(PG8_SB(b, h), (gbase) + (h) * hsB, vB)
#define PG8_STA(b, h, gbase, vg) do { if constexpr (GATHER) { PG8_STAGE(PG8_SA(b, h), gbase, (vg)[h]); } else { PG8_STAGE(PG8_SA(b, h), (gbase) + (h) * hsA, vA); } } while (0)
#define PG8_LDA(dst, b, h) do { _Pragma("unroll") for (int m = 0; m < 4; ++m) _Pragma("unroll") for (int k = 0; k < 2; ++k) dst[m][k] = *(const PG8_LAS bf16x8*)(lds + PG8_SA(b, h) + aoff + m * 2048 + k * 1024); } while (0)
#define PG8_LDB(dst, b, h) do { _Pragma("unroll") for (int n = 0; n < 2; ++n) _Pragma("unroll") for (int k = 0; k < 2; ++k) dst[n][k] = *(const PG8_LAS bf16x8*)(lds + PG8_SB(b, h) + boff + n * 2048 + k * 1024); } while (0)
#define PG8_CAT(x) __builtin_shufflevector(__builtin_bit_cast(i32x4, (x)[0]), __builtin_bit_cast(i32x4, (x)[1]), 0, 1, 2, 3, 4, 5, 6, 7)
#define PG8_MMA(ai, bj, At, Bt) do { __builtin_amdgcn_s_setprio(1); if constexpr (F8) { _Pragma("unroll") for (int m = 0; m < 4; ++m) _Pragma("unroll") for (int n = 0; n < 2; ++n) \
        asm volatile("v_mfma_scale_f32_16x16x128_f8f6f4 %0, %1, %2, %0, %3, %4 op_sel_hi:[0,0,0]" : "+v"(acc[ai][bj][m][n]) : "v"(PG8_CAT(Bt[n])), "v"(PG8_CAT(At[m])), "v"(sclb_), "v"(scla_)); } \
        else if constexpr (I8) { _Pragma("unroll") for (int m = 0; m < 4; ++m) _Pragma("unroll") for (int n = 0; n < 2; ++n) _Pragma("unroll") for (int k = 0; k < 2; ++k) \
        acc[ai][bj][m][n] = __builtin_bit_cast(f32x4, __builtin_amdgcn_mfma_i32_16x16x64_i8(__builtin_bit_cast(i32x4, Bt[n][k]), __builtin_bit_cast(i32x4, At[m][k]), __builtin_bit_cast(i32x4, acc[ai][bj][m][n]), 0, 0, 0)); } \
        else _Pragma("unroll") for (int m = 0; m < 4; ++m) _Pragma("unroll") for (int n = 0; n < 2; ++n) _Pragma("unroll") for (int k = 0; k < 2; ++k) \
        acc[ai][bj][m][n] = __builtin_amdgcn_mfma_f32_16x16x32_bf16(Bt[n][k], At[m][k], acc[ai][bj][m][n], 0, 0, 0); __builtin_amdgcn_s_setprio(0); } while (0)
#define PG8_WAIT_V(n) asm volatile("s_waitcnt vmcnt(" #n ")" ::: "memory")
#define PG8_WAIT_L(n) asm volatile("s_waitcnt lgkmcnt(" #n ")" ::: "memory")
#define PG8_BAR __builtin_amdgcn_s_barrier()
#define PG8_SCHED __builtin_amdgcn_sched_barrier(0)
#define PG8_GIDX(dst, ui_) do { if constexpr (GATHER) { _Pragma("unroll") for (int h = 0; h < 2; ++h) _Pragma("unroll") for (int i = 0; i < 2; ++i) \
        dst[h][i] = ((unsigned)idxc[(ui_) * 256 + HALF * h + RA[i]] * (unsigned)g.lda + (unsigned)CA[i]) * 2u; } } while (0)
    Unit cur, nxt; int ui = 0;
    if (!S.next(0, cur)) return;
    PG8_GIDX(vAc, 0);
    f32x4 acc[2][2][4][2];
#pragma unroll
    for (int a = 0; a < 2; ++a)
#pragma unroll
        for (int b = 0; b < 2; ++b)
#pragma unroll
            for (int m = 0; m < 4; ++m)
#pragma unroll
                for (int n = 0; n < 2; ++n) acc[a][b][m][n] = (f32x4){0.f, 0.f, 0.f, 0.f};
    bf16x8 At[4][2], B0[2][2], B1[2][2];
    const int sclb_ = g.sclb, scla_ = g.scla;
    const char* cA = cur.a; const char* cB = cur.b;
    PG8_STB(0, 0, cB); PG8_STB(0, 1, cB); PG8_STA(0, 0, cA, vAc); PG8_STA(0, 1, cA, vAc);
    if (wr == 1) PG8_BAR;
    PG8_WAIT_V(2); PG8_BAR;
    PG8_STB(1, 0, cB + kstep); PG8_STA(1, 0, cA + kstep, vAc); PG8_STB(1, 1, cB + kstep);
    PG8_WAIT_V(6); PG8_BAR;
    for (;;) {
        const bool has_next = S.next(ui + 1, nxt);
        const char* nA = has_next ? nxt.a : cA; const char* nB = has_next ? nxt.b : cB;
        if constexpr (GATHER) { if (has_next) { PG8_GIDX(vAn, ui + 1); } else {
#pragma unroll
            for (int h = 0; h < 2; ++h)
#pragma unroll
                for (int i = 0; i < 2; ++i) vAn[h][i] = vAc[h][i]; } }
        for (int t = 0; t < nt; t += 2) {
            const bool last = (t == nt - 2);
            const char* a1 = cA + (size_t)(t + 1) * kstep;
            const char* a2 = last ? nA : cA + (size_t)(t + 2) * kstep; const char* b2 = last ? nB : cB + (size_t)(t + 2) * kstep;
            const char* a3 = a2 + kstep; const char* b3 = b2 + kstep;
            unsigned vA2[2][2];
#pragma unroll
            for (int h = 0; h < 2; ++h)
#pragma unroll
                for (int i = 0; i < 2; ++i) vA2[h][i] = (GATHER && last) ? vAn[h][i] : vAc[h][i];
            PG8_LDB(B0, 0, 0); PG8_LDB(B1, 0, 1); PG8_SCHED; PG8_LDA(At, 0, 0); PG8_STA(1, 1, a1, vAc);
            PG8_WAIT_V(8); PG8_WAIT_L(0); PG8_BAR; PG8_MMA(0, 0, At, B0); PG8_MMA(0, 1, At, B1); PG8_BAR; PG8_SCHED;
            PG8_LDA(At, 0, 1); PG8_STB(0, 0, b2); PG8_STB(0, 1, b2); PG8_STA(0, 0, a2, vA2);
            PG8_WAIT_V(8); PG8_WAIT_L(0); PG8_BAR; PG8_MMA(1, 0, At, B0); PG8_MMA(1, 1, At, B1); PG8_BAR; PG8_SCHED;
            PG8_LDB(B0, 1, 0); PG8_LDB(B1, 1, 1); PG8_SCHED; PG8_LDA(At, 1, 0); PG8_STA(0, 1, a2, vA2);
            PG8_WAIT_V(8); PG8_WAIT_L(0); PG8_BAR; PG8_MMA(0, 0, At, B0); PG8_MMA(0, 1, At, B1); PG8_BAR; PG8_SCHED;
            PG8_LDA(At, 1, 1); PG8_STB(1, 0, b3); PG8_STB(1, 1, b3); PG8_STA(1, 0, a3, vA2);
            PG8_WAIT_V(8); PG8_WAIT_L(0); PG8_BAR; PG8_MMA(1, 0, At, B0); PG8_MMA(1, 1, At, B1); PG8_BAR; PG8_SCHED;
        }
        if constexpr (I8 && !epi_raw_i32<Epi>::value) { const float qs = g.qscale;
            _Pragma("unroll") for (int a = 0; a < 2; ++a) _Pragma("unroll") for (int b = 0; b < 2; ++b) _Pragma("unroll") for (int m = 0; m < 4; ++m) _Pragma("unroll") for (int n = 0; n < 2; ++n) _Pragma("unroll") for (int i = 0; i < 4; ++i)
                { const float t_ = acc[a][b][m][n][i]; acc[a][b][m][n][i] = (float)__builtin_bit_cast(int, t_) * qs; } }
        if constexpr (F8) asm volatile("s_nop 15" ::: "memory");
        if constexpr (ALIGN_EPI) { if (wr == 0) PG8_BAR; }
        { int fr_ = fr, fq_ = fq, wr_ = wr, wc_ = wc; asm volatile("" : "+v"(fr_), "+v"(fq_), "+s"(wr_), "+s"(wc_));
          E(acc, cur, wr_, wc_, fr_, fq_); }
        if (!has_next) break;
#pragma unroll
        for (int a = 0; a < 2; ++a)
#pragma unroll
            for (int b = 0; b < 2; ++b)
#pragma unroll
                for (int m = 0; m < 4; ++m)
#pragma unroll
                    for (int n = 0; n < 2; ++n) acc[a][b][m][n] = (f32x4){0.f, 0.f, 0.f, 0.f};
        cur = nxt; cA = nA; cB = nB; ++ui;
        if constexpr (GATHER) {
#pragma unroll
            for (int h = 0; h < 2; ++h)
#pragma unroll
                for (int i = 0; i < 2; ++i) vAc[h][i] = vAn[h][i]; }
        if constexpr (ALIGN_EPI) { if (wr == 1) PG8_BAR; }
    }
    PG8_WAIT_V(0);
    if constexpr (!ALIGN_EPI) { if (wr == 0) PG8_BAR; }
    PG8_BAR;
#undef PG8_SA
#undef PG8_SB
#undef PG8_STAGE
#undef PG8_STA
#undef PG8_STB
#undef PG8_LDA
#undef PG8_LDB
#undef PG8_MMA
#undef PG8_CAT
#undef PG8_WAIT_V
#undef PG8_WAIT_L
#undef PG8_BAR
#undef PG8_SCHED
#undef PG8_GIDX
}
}

#include <hip/hip_bf16.h>
#include <cmath>
namespace attn_body {
using bf16=__hip_bfloat16;
using bf16x8=__attribute__((ext_vector_type(8)))short;
using s16x4=__attribute__((ext_vector_type(4)))short;
using f32x16=__attribute__((ext_vector_type(16)))float;
using u32x4=__attribute__((ext_vector_type(4)))unsigned;
constexpr int BATCH=2,NHEAD=16,SEQ=16384,D=64,DM=NHEAD*D;
#ifndef ATTN_FAST_LIM
#define ATTN_FAST_LIM 3600.f
#endif
constexpr int NW=8,QBLK=32,QB=QBLK*NW,KVBLK=64,NQB=SEQ/QB;
constexpr int ATTN_PITCH=DM, ATTN_UNIT_ROWS=QB;
__device__ __forceinline__ int crow(int r,int hi){return (r&3)+8*(r>>2)+4*hi;}
#define SBAR() __builtin_amdgcn_sched_barrier(0)
__device__ __forceinline__ void cmask(f32x16&p0,f32x16&p1,int jb,int qrel,int hi){
  const float NEG=-INFINITY; int kb=64*jb+4*hi;
  #pragma unroll
  for(int r=0;r<16;++r){int kv=kb+(r&3)+8*(r>>2); if(kv>qrel)p0[r]=NEG; if(kv+32>qrel)p1[r]=NEG;}
}

constexpr int NSLOT=3, SLOTB=8192, DV=128;
constexpr int LDS_K=0, LDS_V=NSLOT*SLOTB, LDS_WS=3*NSLOT*SLOTB, LDS_OST=LDS_WS+NW*64*4, LDS_BYTES=LDS_OST+NW*4096;
constexpr float C2=0.125f*1.4426950408889634f;
__device__ __forceinline__ void glds16(const void*gsrc,unsigned lds_dst){unsigned keep;
  asm volatile("s_mov_b32 %0, m0\n\ts_mov_b32 m0, %2\n\ts_nop 0\n\tglobal_load_lds_dwordx4 %1, off\n\ts_mov_b32 m0, %0":"=&s"(keep):"v"(gsrc),"s"(lds_dst):"memory");}
__device__ __forceinline__ float max3f(float a,float b,float c){float r;asm("v_max3_f32 %0, %1, %2, %3":"=v"(r):"v"(a),"v"(b),"v"(c));return r;}
__device__ __forceinline__ float max2f(float a,float b){float r;asm("v_max_f32_e32 %0, %1, %2":"=v"(r):"v"(a),"v"(b));return r;}
__device__ __forceinline__ float fadd_s(float a,float b){float r;asm("v_add_f32_e32 %0, %1, %2":"=v"(r):"v"(a),"v"(b));return r;}
__device__ __forceinline__ float fsub_s(float a,float b){float r;asm("v_sub_f32_e32 %0, %1, %2":"=v"(r):"v"(a),"v"(b));return r;}
typedef float f32x2_t __attribute__((ext_vector_type(2))); typedef __bf16 bf16x2_t __attribute__((ext_vector_type(2)));
__device__ __forceinline__ unsigned cvtpk_s(float lo,float hi){f32x2_t v={lo,hi};bf16x2_t b=__builtin_convertvector(v,bf16x2_t);return __builtin_bit_cast(unsigned,b);}
__device__ __forceinline__ unsigned pk4_i8a(float a,float b,float c,float d){
  const unsigned u0=__builtin_bit_cast(unsigned,__builtin_amdgcn_fmed3f(a,-127.f,127.f)+12582912.f),u1=__builtin_bit_cast(unsigned,__builtin_amdgcn_fmed3f(b,-127.f,127.f)+12582912.f);
  const unsigned u2=__builtin_bit_cast(unsigned,__builtin_amdgcn_fmed3f(c,-127.f,127.f)+12582912.f),u3=__builtin_bit_cast(unsigned,__builtin_amdgcn_fmed3f(d,-127.f,127.f)+12582912.f);
  return __builtin_amdgcn_perm(u1,u0,0x0c0c0400u)|__builtin_amdgcn_perm(u3,u2,0x04000c0cu);}
#define WAIT_BAR(N) asm volatile("s_waitcnt vmcnt(" #N ") lgkmcnt(0)\n\ts_barrier":::"memory")

__device__ __forceinline__ void qkt(f32x16&p0,f32x16&p1,const char*Kslot,const bf16x8*qr,int r32,int hi){ const f32x16 negm=f32x16{};
  const char*kb=Kslot+hi*1024+r32*16;
  #pragma unroll
  for(int d0=0;d0<4;++d0){
    const bf16x8 b0=*reinterpret_cast<const bf16x8*>(kb+d0*2048);
    const bf16x8 b1=*reinterpret_cast<const bf16x8*>(kb+d0*2048+512);
    if(d0==0){p0=__builtin_amdgcn_mfma_f32_32x32x16_bf16(b0,qr[0],negm,0,0,0);p1=__builtin_amdgcn_mfma_f32_32x32x16_bf16(b1,qr[0],negm,0,0,0);}
    else{p0=__builtin_amdgcn_mfma_f32_32x32x16_bf16(b0,qr[d0],p0,0,0,0);p1=__builtin_amdgcn_mfma_f32_32x32x16_bf16(b1,qr[d0],p1,0,0,0);}}
}
typedef __attribute__((address_space(3))) const char* lds_cptr;
typedef short v4i16_t __attribute__((ext_vector_type(4)));
__device__ __forceinline__ void kload8(bf16x8*kf,lds_cptr kp){
  kf[0]=*(const __attribute__((address_space(3))) bf16x8*)(kp);      kf[1]=*(const __attribute__((address_space(3))) bf16x8*)(kp+512);
  kf[2]=*(const __attribute__((address_space(3))) bf16x8*)(kp+2048); kf[3]=*(const __attribute__((address_space(3))) bf16x8*)(kp+2560);
  kf[4]=*(const __attribute__((address_space(3))) bf16x8*)(kp+4096); kf[5]=*(const __attribute__((address_space(3))) bf16x8*)(kp+4608);
  kf[6]=*(const __attribute__((address_space(3))) bf16x8*)(kp+6144); kf[7]=*(const __attribute__((address_space(3))) bf16x8*)(kp+6656);
}
__device__ __forceinline__ void kload2(bf16x8*kf,lds_cptr kp,int j){ kf[2*j]=*(const __attribute__((address_space(3))) bf16x8*)(kp+j*2048); kf[2*j+1]=*(const __attribute__((address_space(3))) bf16x8*)(kp+j*2048+512); }
__device__ __forceinline__ s16x4 vtr(lds_cptr p){ return __builtin_bit_cast(s16x4,__builtin_amdgcn_ds_read_tr16_b64_v4i16((__attribute__((address_space(3))) v4i16_t*)p)); }
__device__ __forceinline__ float rowmax(const f32x16&p0,const f32x16&p1){
  float a=max3f(p0[0],p0[1],p1[0]),b=max3f(p0[2],p0[3],p1[1]);a=max3f(a,p1[2],p1[3]);
  #pragma unroll
  for(int r=4;r<16;r+=4){a=max3f(a,p0[r],p0[r+1]);b=max3f(b,p0[r+2],p0[r+3]);a=max3f(a,p1[r],p1[r+1]);b=max3f(b,p1[r+2],p1[r+3]);}
  const float m=max2f(a,b);
  auto rr=__builtin_amdgcn_permlane32_swap(__float_as_uint(m),__float_as_uint(m),false,false);
  return max2f(__uint_as_float(rr[0]),__uint_as_float(rr[1]));
}
__device__ __forceinline__ void pv(f32x16*o,int vb,bf16x8 pa0,bf16x8 pa1,bf16x8 pa2,bf16x8 pa3){
  #pragma unroll
  for(int d0=0;d0<4;++d0){s16x4 lo[4],hi[4];
    #pragma unroll
    for(int ks=0;ks<4;++ks){
      asm volatile("ds_read_b64_tr_b16 %0,%1 offset:%c2":"=&v"(lo[ks]):"v"(vb),"i"(d0*4096+ks*1024):"memory");
      asm volatile("ds_read_b64_tr_b16 %0,%1 offset:%c2":"=&v"(hi[ks]):"v"(vb),"i"(d0*4096+ks*1024+512):"memory");}
    asm volatile("s_waitcnt lgkmcnt(0)":::"memory");SBAR();
    #define PK(k) (bf16x8){lo[k][0],lo[k][1],lo[k][2],lo[k][3],hi[k][0],hi[k][1],hi[k][2],hi[k][3]}
    o[d0]=__builtin_amdgcn_mfma_f32_32x32x16_bf16(pa0,PK(0),o[d0],0,0,0);
    o[d0]=__builtin_amdgcn_mfma_f32_32x32x16_bf16(pa1,PK(1),o[d0],0,0,0);
    o[d0]=__builtin_amdgcn_mfma_f32_32x32x16_bf16(pa2,PK(2),o[d0],0,0,0);
    o[d0]=__builtin_amdgcn_mfma_f32_32x32x16_bf16(pa3,PK(3),o[d0],0,0,0);
    #undef PK
  }
}

#ifndef ATTN_STORE16
#define ATTN_STORE16(p,v) (*(u32x4*)(p)=(v))
#endif
struct CombArgs{ unsigned char*OB; float lam; const float*subg; float oscale,sub_eps; };
template<int THRL,bool FAST,bool COMB> __device__ __forceinline__ void attn_unit(int b,int h,int p,int qb,const bf16*Q,const bf16*__restrict__ K,const bf16*__restrict__ V,bf16*O,char*shm,const CombArgs ca){
  int tid=threadIdx.x; asm volatile("":"+v"(tid));
  const int lane=tid&63,r32=lane&31,hi=lane>>5; const int wid=__builtin_amdgcn_readfirstlane(tid>>6);
  const long rowbase=(long)b*SEQ; const int q0=qb*QB;
  const int hq=2*h+p; const bf16*Qw=Q+(rowbase+q0+wid*QBLK)*DM+hq*D;
  const bf16*Kh=K+rowbase*DM+hq*D,*Vh=V+rowbase*DM+h*DV;
  const unsigned lds0=(unsigned)(uintptr_t)shm;
  float*wsf=(float*)(shm+LDS_WS)+wid*64;
  const bf16*ksrc=Kh+(long)lane*DM+wid*8;
  const bf16*vsrc=Vh+(long)(16*(wid&3)+(lane>>2))*DM+(wid>>2)*32+(lane&3)*8;
  const unsigned kdst=lds0+LDS_K+wid*1024, vdst=lds0+LDS_V+wid*1024;
  #define DMA_K(t,slot) glds16(ksrc+(long)(t)*KVBLK*DM,(unsigned)__builtin_amdgcn_readfirstlane(kdst+(slot)))
  #define DMA_V(t,slot) do{ glds16(vsrc+(long)(t)*KVBLK*DM,(unsigned)__builtin_amdgcn_readfirstlane(vdst+2*(slot))); glds16(vsrc+(long)(t)*KVBLK*DM+64,(unsigned)__builtin_amdgcn_readfirstlane(vdst+2*(slot)+8192)); }while(0)
  const int vb0=(int)(lds0+LDS_V)+((lane>>4)&1)*32+(lane&3)*8+(4*hi+((lane&15)>>2))*64;
  const char*Kbase=shm+LDS_K; bf16x8 kf[8];
  const lds_cptr shm3=(lds_cptr)shm; const lds_cptr kp0=shm3+LDS_K+hi*1024+r32*16; const lds_cptr vp0=shm3+LDS_V+((lane>>4)&1)*32+(lane&3)*8+(4*hi+((lane&15)>>2))*64;
  const int NT=(q0+QB)/KVBLK;
  DMA_K(0,0);DMA_V(0,0);DMA_K(1,SLOTB);
  bf16x8 qr[4];
  #pragma unroll
  for(int d0=0;d0<4;++d0)qr[d0]=*reinterpret_cast<const bf16x8*>(&Qw[(long)r32*DM+d0*16+hi*8]);
  float mhat=0.f,l_reg=0.f;f32x16 o[4];o[0]=f32x16{};o[1]=f32x16{};o[2]=f32x16{};o[3]=f32x16{};
  const int qrel=wid*QBLK+r32;
  #define CMASK(P0,P1,t) do{int jb_=(t)-(NT-4); if(jb_>=0)cmask(P0,P1,jb_,qrel,hi);}while(0)
  bool resc=false;
  #define START(P0,P1) do{ if constexpr(!FAST){ const float rm=rowmax(P0,P1); resc=false; \
    { const float dl=rm; mhat=fadd_s(mhat,dl); \
      _Pragma("unroll") for(int r=0;r<16;++r){P0[r]=fsub_s(P0[r],dl);P1[r]=fsub_s(P1[r],dl);} \
      } } \
    _Pragma("unroll") for(int r=0;r<16;++r)P0[r]=__builtin_amdgcn_exp2f(P0[r]); }while(0)
  #define RESC() do{ if constexpr(!FAST){ if(resc){ asm volatile("s_waitcnt lgkmcnt(0)":::"memory"); \
      _Pragma("unroll") for(int d_=0;d_<4;++d_) _Pragma("unroll") for(int r=0;r<16;++r)o[d_][r]*=wsf[crow(r,hi)]; } } }while(0)
  f32x16 pA0,pA1,pB0,pB1;
  int sl_prev=0,sl_cur=0,sl_next=SLOTB;
  #define ROT() do{sl_prev=sl_cur;sl_cur=sl_next;sl_next=(sl_next==(NSLOT-1)*SLOTB)?0:sl_next+SLOTB;}while(0)
  DMA_K(2,2*SLOTB);
  WAIT_BAR(4);
  qkt(pA0,pA1,Kbase,qr,r32,hi);asm volatile("s_nop 15\n\ts_nop 7":"+v"(pA0),"+v"(pA1));CMASK(pA0,pA1,0);
  START(pA0,pA1);
  _Pragma("unroll") for(int r=0;r<16;++r)pA1[r]=__builtin_amdgcn_exp2f(pA1[r]);
  WAIT_BAR(0);
  DMA_K(3,0);DMA_V(1,SLOTB);
  ROT();
  kload8(kf,kp0+sl_cur);
  WAIT_BAR(3);
  s16x4 vlo[16],vhi[16]; u32x4 pw0,pw1,pw2,pw3;
  #define PKW(P,B) cvtpk_s(P[B],P[B+1])
  #define PAF(k) __builtin_bit_cast(bf16x8,pw##k)
  #define VFR(i) (bf16x8){vlo[i][0],vlo[i][1],vlo[i][2],vlo[i][3],vhi[i][0],vhi[i][1],vhi[i][2],vhi[i][3]}
  #define PIN(x) asm volatile("":"+v"(x))
  #define MX3(a,b,c) __builtin_fmaxf(__builtin_fmaxf((a),(b)),(c))
  #define GAPA(MF,A0,A1,A2,A3,W0,W1,PW) do{ MF; sacc+=A0; sacc+=A1; sacc+=A2; sacc+=A3; PIN(sacc); W0; W1; PIN(PW); SBAR(); }while(0)
  #define EX(v) __builtin_amdgcn_exp2f(v)
  #define ZERO16 (f32x16{})
  #define GAPB(MF,X,B) do{ MF; if constexpr(FAST){X[B]=EX(X[B]); X[B+1]=EX(X[B+1]);}else{X[B]=EX(X[B]-mhat); X[B+1]=EX(X[B+1]-mhat);} PIN(X); SBAR(); }while(0)
  #define VRD(i) do{ vlo[i]=vtr(vp_+(((i)>>2)*4096+((i)&3)*1024)); vhi[i]=vtr(vp_+(((i)>>2)*4096+((i)&3)*1024+512)); }while(0)
  #define KRD(G,j) do{ if(G){ kload2(kf,kp0+sl_next,j); SBAR(); } }while(0)
  #define STEP(C0,C1,P0,P1,t,GK,GV,GL) do{ SBAR(); \
    const lds_cptr vp_=vp0+2*sl_prev; \
    float sacc=(P0[0]+P0[1]); \
    GAPA(C0=__builtin_amdgcn_mfma_f32_32x32x16_bf16(kf[0],qr[0],ZERO16,0,0,0), P0[2],P0[3],P0[4],P0[5],     pw0[0]=PKW(P0,0), pw0[1]=PKW(P0,2), pw0); \
    GAPA(C1=__builtin_amdgcn_mfma_f32_32x32x16_bf16(kf[1],qr[0],ZERO16,0,0,0), P0[6],P0[7],P0[8],P0[9],     pw0[2]=PKW(P0,4), pw0[3]=PKW(P0,6), pw0); \
    VRD(0); SBAR(); GAPA(C0=__builtin_amdgcn_mfma_f32_32x32x16_bf16(kf[2],qr[1],C0,0,0,0),   P0[10],P0[11],P0[12],P0[13], pw1[0]=PKW(P0,8), pw1[1]=PKW(P0,10), pw1); \
    VRD(4); SBAR(); GAPA(C1=__builtin_amdgcn_mfma_f32_32x32x16_bf16(kf[3],qr[1],C1,0,0,0),   P0[14],P0[15],P1[0],P1[1],   pw1[2]=PKW(P0,12),pw1[3]=PKW(P0,14), pw1); \
    VRD(8); SBAR(); GAPA(C0=__builtin_amdgcn_mfma_f32_32x32x16_bf16(kf[4],qr[2],C0,0,0,0),   P1[2],P1[3],P1[4],P1[5],     pw2[0]=PKW(P1,0), pw2[1]=PKW(P1,2), pw2); \
    VRD(12); SBAR(); GAPA(C1=__builtin_amdgcn_mfma_f32_32x32x16_bf16(kf[5],qr[2],C1,0,0,0),   P1[6],P1[7],P1[8],P1[9],     pw2[2]=PKW(P1,4), pw2[3]=PKW(P1,6), pw2); \
    VRD(1); SBAR(); GAPA(C0=__builtin_amdgcn_mfma_f32_32x32x16_bf16(kf[6],qr[3],C0,0,0,0),   P1[10],P1[11],P1[12],P1[13], pw3[0]=PKW(P1,8), pw3[1]=PKW(P1,10), pw3); \
    VRD(5); SBAR(); GAPA(C1=__builtin_amdgcn_mfma_f32_32x32x16_bf16(kf[7],qr[3],C1,0,0,0),   P1[14],P1[15],0.f,0.f,       pw3[2]=PKW(P1,12),pw3[3]=PKW(P1,14), pw3); \
    l_reg+=sacc; \
    if(GK){DMA_K((t)+3,sl_cur);} if(GV){DMA_V((t)+1,sl_next);} \
    CMASK(C0,C1,t); \
    if constexpr(!FAST){ float a=MX3(C0[0],C0[1],C1[0]),b=MX3(C0[2],C0[3],C1[1]); a=MX3(a,C1[2],C1[3]); \
      _Pragma("unroll") for(int r=4;r<16;r+=4){a=MX3(a,C0[r],C0[r+1]);b=MX3(b,C0[r+2],C0[r+3]);a=MX3(a,C1[r],C1[r+1]);b=MX3(b,C1[r+2],C1[r+3]);} \
      float rm=__builtin_fmaxf(a,b); { auto rr=__builtin_amdgcn_permlane32_swap(__float_as_uint(rm),__float_as_uint(rm),false,false); rm=__builtin_fmaxf(__uint_as_float(rr[0]),__uint_as_float(rr[1])); } \
      resc=false; \
      rm-=mhat; \
      if(__builtin_expect(__any(rm>(float)THRL),0)){ const float dl=__builtin_fmaxf(rm,0.f); mhat+=dl; \
        const float f=__builtin_amdgcn_exp2f(-dl); l_reg*=f; if(hi==0)wsf[r32]=f; resc=true; } } \
    SBAR(); \
    VRD(9); SBAR(); GAPB(o[0]=__builtin_amdgcn_mfma_f32_32x32x16_bf16(PAF(0),VFR(0),o[0],0,0,0), C0,0); \
    VRD(13); SBAR(); GAPB(o[1]=__builtin_amdgcn_mfma_f32_32x32x16_bf16(PAF(0),VFR(4),o[1],0,0,0), C0,2); \
    VRD(2); SBAR(); GAPB(o[2]=__builtin_amdgcn_mfma_f32_32x32x16_bf16(PAF(0),VFR(8),o[2],0,0,0), C0,4); \
    VRD(6); SBAR(); GAPB(o[3]=__builtin_amdgcn_mfma_f32_32x32x16_bf16(PAF(0),VFR(12),o[3],0,0,0), C0,6); \
    VRD(10); SBAR(); GAPB(o[0]=__builtin_amdgcn_mfma_f32_32x32x16_bf16(PAF(1),VFR(1),o[0],0,0,0), C0,8); \
    VRD(14); SBAR(); GAPB(o[1]=__builtin_amdgcn_mfma_f32_32x32x16_bf16(PAF(1),VFR(5),o[1],0,0,0), C0,10); \
    VRD(3); SBAR(); GAPB(o[2]=__builtin_amdgcn_mfma_f32_32x32x16_bf16(PAF(1),VFR(9),o[2],0,0,0), C0,12); \
    VRD(7); SBAR(); GAPB(o[3]=__builtin_amdgcn_mfma_f32_32x32x16_bf16(PAF(1),VFR(13),o[3],0,0,0), C0,14); \
    VRD(11); SBAR(); GAPB(o[0]=__builtin_amdgcn_mfma_f32_32x32x16_bf16(PAF(2),VFR(2),o[0],0,0,0), C1,0); \
    VRD(15); SBAR(); GAPB(o[1]=__builtin_amdgcn_mfma_f32_32x32x16_bf16(PAF(2),VFR(6),o[1],0,0,0), C1,2); \
    KRD(GL,0); GAPB(o[2]=__builtin_amdgcn_mfma_f32_32x32x16_bf16(PAF(2),VFR(10),o[2],0,0,0), C1,4); \
    KRD(GL,1); GAPB(o[3]=__builtin_amdgcn_mfma_f32_32x32x16_bf16(PAF(2),VFR(14),o[3],0,0,0), C1,6); \
    KRD(GL,2); GAPB(o[0]=__builtin_amdgcn_mfma_f32_32x32x16_bf16(PAF(3),VFR(3),o[0],0,0,0), C1,8); \
    KRD(GL,3); GAPB(o[1]=__builtin_amdgcn_mfma_f32_32x32x16_bf16(PAF(3),VFR(7),o[1],0,0,0), C1,10); \
    GAPB(o[2]=__builtin_amdgcn_mfma_f32_32x32x16_bf16(PAF(3),VFR(11),o[2],0,0,0), C1,12); \
    GAPB(o[3]=__builtin_amdgcn_mfma_f32_32x32x16_bf16(PAF(3),VFR(15),o[3],0,0,0), C1,14); \
    }while(0)
  int t=1;
  #undef CMASK
  #define CMASK(P0,P1,t) do{}while(0)
  for(;t+5<NT;t+=2){
    STEP(pB0,pB1,pA0,pA1,t,true,true,true);     WAIT_BAR(3); RESC(); ROT();
    STEP(pA0,pA1,pB0,pB1,t+1,true,true,true);   WAIT_BAR(3); RESC(); ROT();
  }
  #undef CMASK
  #define CMASK(P0,P1,t) do{int jb_=(t)-(NT-4); if(jb_>=0)cmask(P0,P1,jb_,qrel,hi);}while(0)
  #define ENDW(tt) do{ if((tt)+3<NT){WAIT_BAR(3);} else if((tt)+2<NT){WAIT_BAR(2);} else {WAIT_BAR(0);} }while(0)
  for(;t+1<NT;t+=2){
    STEP(pB0,pB1,pA0,pA1,t,(t+3<NT),(t+1<NT),(t+1<NT));       ENDW(t);   RESC(); ROT();
    STEP(pA0,pA1,pB0,pB1,t+1,(t+4<NT),(t+2<NT),(t+2<NT));     ENDW(t+1); RESC(); ROT();
  }
  STEP(pB0,pB1,pA0,pA1,NT-1,false,false,false); RESC();
  { float sacc=pB0[0]+pB0[1]; _Pragma("unroll") for(int r=2;r<16;++r)sacc+=pB0[r]; _Pragma("unroll") for(int r=0;r<16;++r)sacc+=pB1[r]; l_reg+=sacc;
    pw0=(u32x4){PKW(pB0,0),PKW(pB0,2),PKW(pB0,4),PKW(pB0,6)};pw1=(u32x4){PKW(pB0,8),PKW(pB0,10),PKW(pB0,12),PKW(pB0,14)};pw2=(u32x4){PKW(pB1,0),PKW(pB1,2),PKW(pB1,4),PKW(pB1,6)};pw3=(u32x4){PKW(pB1,8),PKW(pB1,10),PKW(pB1,12),PKW(pB1,14)};
    SBAR(); pv(o,vb0+2*sl_cur,PAF(0),PAF(1),PAF(2),PAF(3)); }
  #undef PKW
  #undef PAF
  #undef VFR
  #undef PIN
  #undef MX3
  #undef GAPA
  #undef GAPB
  #undef EX
  #undef VRD
  #undef KRD
  #undef STEP
  #undef ENDW
  {auto rr=__builtin_amdgcn_permlane32_swap(__float_as_uint(l_reg),__float_as_uint(l_reg),false,false);l_reg=__uint_as_float(rr[0])+__uint_as_float(rr[1]);}
  if(hi==0)wsf[32+r32]=l_reg;asm volatile("s_waitcnt lgkmcnt(0)":::"memory");
  float rli[16];
  #pragma unroll
  for(int r=0;r<16;++r)rli[r]=__builtin_amdgcn_rcpf(wsf[32+crow(r,hi)]);
  bf16*Ow=O+(rowbase+q0+wid*QBLK)*DM+h*DV;
  { bf16*stg=(bf16*)(shm+LDS_OST)+wid*2048;
    u32x4 a0[2][4]; float y[2][4][8]; float ss[4]={0.f,0.f,0.f,0.f};
    if constexpr(COMB){
      #pragma unroll
      for(int hf=0;hf<2;++hf){
        #pragma unroll
        for(int i=0;i<4;++i){const int row=i*8+(lane>>3),ch=lane&7; a0[hf][i]=*(const u32x4*)(Ow+(long)row*DM+hf*64+ch*8);} } }
    #pragma unroll
    for(int hf=0;hf<2;++hf){
      #pragma unroll
      for(int r=0;r<16;++r){const int orow=crow(r,hi);
        #pragma unroll
        for(int d0=0;d0<2;++d0)stg[orow*64+d0*32+r32]=__float2bfloat16(o[2*hf+d0][r]*rli[r]);}
      asm volatile("s_waitcnt lgkmcnt(0)":::"memory");
      #pragma unroll
      for(int i=0;i<4;++i){const int row=i*8+(lane>>3),ch=lane&7; const u32x4 v=*(const u32x4*)(stg+row*64+ch*8);
        if constexpr(COMB){ const u32x4 a=a0[hf][i];
          #pragma unroll
          for(int q=0;q<4;++q){ const float y0=__uint_as_float(a[q]<<16)-ca.lam*__uint_as_float(v[q]<<16), y1=__uint_as_float(a[q]&0xffff0000u)-ca.lam*__uint_as_float(v[q]&0xffff0000u);
            y[hf][i][2*q]=y0; y[hf][i][2*q+1]=y1; ss[i]+=y0*y0+y1*y1; } }
        else ATTN_STORE16(Ow+(long)row*DM+hf*64+ch*8,v);}
      asm volatile("s_waitcnt lgkmcnt(0)":::"memory"); }
    if constexpr(COMB){
      unsigned char*OBw=ca.OB+(rowbase+q0+wid*QBLK)*DM+h*DV;
      #pragma unroll
      for(int i=0;i<4;++i){ float t=ss[i]; t+=__shfl_xor(t,1);t+=__shfl_xor(t,2);t+=__shfl_xor(t,4);
        const float rs=__builtin_amdgcn_rsqf(t*(1.f/128.f)+ca.sub_eps)*ca.oscale; const int row=i*8+(lane>>3),ch=lane&7;
        #pragma unroll
        for(int hf=0;hf<2;++hf){ const float*gp=ca.subg+hf*64+ch*8;
          const unsigned w0=pk4_i8a(y[hf][i][0]*rs*gp[0],y[hf][i][1]*rs*gp[1],y[hf][i][2]*rs*gp[2],y[hf][i][3]*rs*gp[3]),w1=pk4_i8a(y[hf][i][4]*rs*gp[4],y[hf][i][5]*rs*gp[5],y[hf][i][6]*rs*gp[6],y[hf][i][7]*rs*gp[7]);
          *(unsigned long long*)(OBw+(long)row*DM+hf*64+ch*8)=(unsigned long long)w0|((unsigned long long)w1<<32); } } } }
  asm volatile("s_waitcnt lgkmcnt(0)\n\ts_barrier":::"memory");
  #undef DMA_K
  #undef DMA_V
  #undef CMASK
  #undef START
  #undef RESC
  #undef ROT
}
constexpr int ATTN_LDS_BYTES=LDS_BYTES;
template<int THRL=8> __device__ __forceinline__ void attn_phase(char*lds,const bf16*Q,const bf16*K,const bf16*V,bf16*OS0,bf16*OS1,bf16*OB,const unsigned*nrm,float lam,const float*subg,float oscale,float sub_eps,int vcu,int G){
  for(int item=vcu;item<16*32;item+=G){
    const int bh=item>>5,pr=item&31; const int b=bh>>3,h=bh&7;
    for(int j=0;j<2;++j){ const int qb=j?pr:63-pr;
      const CombArgs ca{(unsigned char*)OB,lam,subg,oscale,sub_eps};
      for(int p=0;p<2;++p){
        const float k2=__uint_as_float(__builtin_amdgcn_readfirstlane(nrm[b*16+2*h+p])),q2=__uint_as_float(__builtin_amdgcn_readfirstlane(nrm[(2+b)*16+2*h+p]));
        const bool fast=(k2*q2<=ATTN_FAST_LIM);
        if(p==0){ if(fast)attn_unit<THRL,true,false>(b,h,0,qb,Q,K,V,OS0,lds,ca); else attn_unit<THRL,false,false>(b,h,0,qb,Q,K,V,OS0,lds,ca); }
        else    { if(fast)attn_unit<THRL,true,true>(b,h,1,qb,Q,K,V,OS0,lds,ca); else attn_unit<THRL,false,true>(b,h,1,qb,Q,K,V,OS0,lds,ca); } }
    }
  }
}
#undef SBAR
#undef WAIT_BAR
}
constexpr int NWAVES = 8;
constexpr int BATCH = 2, SEQ = 16384, TOK = BATCH * SEQ, DM = 1024;
constexpr int RH = 4, RC = 512, NCH = SEQ / RC, PXP = RC + 256, VTP = NCH * PXP;
constexpr int DFF = 2816, NE = 8, DFE = 3584;
constexpr int MAXMT = 2 * TOK / 256 + NE, SLOTS = MAXMT * 256;
constexpr float NORM_EPS = 1e-6f, SUBLN_EPS = 1e-5f, LAMBDA_INIT = 0.35550906759096934f;
constexpr float L2THETA = 13.287712379549449f, INV2PI = 0.15915494309189535f;
constexpr float ASC8 = 4.f, WDSC8 = 512.f;
constexpr int E8_ACT = 0x7d7d7d7d, E8_WD = 0x76767676;
constexpr float ASCI = 16.f, WDSCI_D = 3000.f, WDSCI_M = 3380.f;
constexpr float OSCI = 40.f, WOSCI = 1800.f;
constexpr float GSCI = 16.f, WOUTSCI = 2800.f;
constexpr float YSCI = 80.f;
constexpr float XSCI = 28.f, WSCI = 1000.f;
constexpr float C2Q = 0.18033688011112042f;

constexpr size_t MiB = 1u << 20;
constexpr size_t WS_CTL = 0, CTL_ZERO_BYTES = 1 * MiB;
constexpr size_t WS_PART = 1 * MiB;
constexpr size_t WS_WIN = 1 * MiB;
constexpr size_t WS_WOUT = 13 * MiB;
constexpr size_t WS_WGU = 17 * MiB;
constexpr size_t WS_WD = 28 * MiB;
constexpr size_t WS_WKVQ = 33 * MiB + MiB / 2;
constexpr size_t WS_WO = 39 * MiB + MiB / 2;
constexpr size_t WS_SSP = 42 * MiB;
constexpr size_t WS_TOKE = 44 * MiB;
constexpr size_t WS_TOKW = WS_TOKE + 256 * 1024;
constexpr size_t WS_TOKR = WS_TOKW + 256 * 1024;
constexpr size_t WS_HIST = WS_TOKR + 128 * 1024;
constexpr size_t WS_SLOTT = 45 * MiB;
constexpr size_t WS_SLOTW = 45 * MiB + 512 * 1024;
constexpr size_t WS_XB = 50 * MiB;
constexpr size_t WS_OG = 114 * MiB;
constexpr size_t WS_QT = 242 * MiB, WS_KT = 274 * MiB, WS_KTT = 306 * MiB, WS_VTE = 338 * MiB, WS_PEX = 434 * MiB;
constexpr size_t WS_ACT = 114 * MiB;
constexpr size_t WS_O0 = 50 * MiB, WS_K = 114 * MiB, WS_V = 178 * MiB, WS_Q = 242 * MiB, WS_OB = 242 * MiB, WS_O1 = 306 * MiB;
constexpr size_t WS_ACTM = 82 * MiB, WS_Y = 313 * MiB, WS_WMGU = 445 * MiB, WS_WMD = 501 * MiB;
constexpr size_t WS_TOKS = WS_HIST + 64 * 1024;
constexpr size_t WS_XR = 380 * MiB;
constexpr size_t WS_OB8 = 445 * MiB;
constexpr size_t WS_END = 530 * MiB;
static_assert(WS_PEX + (size_t)RH * SEQ * PXP * 2 <= WS_END && WS_VTE + (size_t)2048 * VTP * 2 <= WS_PEX && WS_XB + (size_t)TOK * DM <= WS_ACTM && WS_ACTM + (size_t)SLOTS * DFE <= WS_Y && WS_Y + (size_t)SLOTS * DM <= WS_XR && WS_XR + (size_t)TOK * DM * 2 <= WS_WMGU && WS_OB8 + (size_t)TOK * DM <= WS_END && (size_t)SLOTS * 4 <= 512 * 1024 && WS_WMGU + (size_t)NE * 7168 * DM <= WS_WMD && WS_TOKS + (size_t)TOK * 8 <= WS_SLOTT && WS_WMGU + (size_t)NE * 7168 * DM <= WS_WMD && WS_WMD + (size_t)NE * 1024 * DFE <= WS_END, "d_ws map");
constexpr int CW_TMO = 0, CW_CODE = 1, CW_NRM = 512, CW_BAR = 4096;

constexpr int RING_OFF = 0, RING_BYTES = 131072;
constexpr int MISC_OFF = RING_BYTES;
constexpr int SEG_OFF = MISC_OFF + 256;
constexpr int IDXC_OFF = MISC_OFF + 1024;
constexpr int LDS_BYTES = 155648;
constexpr int IDXC_UNITS = (LDS_BYTES - IDXC_OFF) / 512;

#define GAS __attribute__((address_space(1)))
#define LAS __attribute__((address_space(3)))
typedef unsigned short bf16;
typedef unsigned v4u __attribute__((ext_vector_type(4)));
typedef float f32x4 __attribute__((ext_vector_type(4)));
typedef GAS unsigned gu32;
#define RLX_AGENT __ATOMIC_RELAXED, __HIP_MEMORY_SCOPE_AGENT
#define LDS_WAIT() asm volatile("s_waitcnt lgkmcnt(0)" ::: "memory")
#define VM_WAIT() asm volatile("s_waitcnt vmcnt(0)" ::: "memory")
__device__ __forceinline__ unsigned f2bf(float f) { unsigned u = __builtin_bit_cast(unsigned, f); return (u + 0x7fffu + ((u >> 16) & 1u)) >> 16; }
__device__ __forceinline__ unsigned pk2(float lo, float hi) { return f2bf(lo) | (f2bf(hi) << 16); }
__device__ __forceinline__ float bf2f(unsigned short b) { return __builtin_bit_cast(float, (unsigned)b << 16); }
__device__ __forceinline__ float bflo(unsigned w) { return __builtin_bit_cast(float, w << 16); }
__device__ __forceinline__ float bfhi(unsigned w) { return __builtin_bit_cast(float, w & 0xffff0000u); }
__device__ __forceinline__ float log2gamma(int h) { return h == 0 ? -0.04580368961312479f : h == 1 ? -0.02272007650008353f : h == 2 ? -0.011315313227834146f : -0.005646563141142063f; }
__device__ __forceinline__ float sigmoidf_(float x) { return __builtin_amdgcn_rcpf(1.f + __builtin_amdgcn_exp2f(-1.4426950408889634f * x)); }
#define XB_TMO      128
#define XB_XCNT(j)  (256  + 64 * (j))
#define XB_XSUB(j)  (1280 + 64 * (j))
#define XB_XGEN(j)  (2304 + 64 * (j))
#define XB_TOP      3328
#define XB_TOPGEN   3392
#define XCD_BAR_WORDS 3456
#define XB_SPIN_CAP (1u << 18)

__device__ __forceinline__ unsigned xb_ld(unsigned* p)              { return __hip_atomic_load(p, __ATOMIC_RELAXED, __HIP_MEMORY_SCOPE_AGENT); }
__device__ __forceinline__ unsigned xb_add(unsigned* p, unsigned v) { return __hip_atomic_fetch_add(p, v, __ATOMIC_RELAXED, __HIP_MEMORY_SCOPE_AGENT); }
__device__ __forceinline__ unsigned xb_xcc_id() { return (unsigned)__builtin_amdgcn_s_getreg((3 << 11) | 20) & 0xFu; }
#define XB_SPIN(cond, bar) do { unsigned _sp = 0; while (cond) { __builtin_amdgcn_s_sleep(1); \
    if ((++_sp & 255u) == 0u) { if (xb_ld(&(bar)[XB_TMO])) break; if (_sp > XB_SPIN_CAP) { atomicAdd(&(bar)[XB_TMO], 1u); break; } } } } while (0)

struct XcdBarrier {
    unsigned* bar; unsigned x;
    volatile LAS unsigned* st;
};

__device__ __forceinline__ XcdBarrier xcd_barrier_post(unsigned* bar, volatile LAS unsigned* st) {
    XcdBarrier b; b.bar = bar; b.x = xb_xcc_id(); b.st = st;
    if (threadIdx.x == 0) (void)xb_add(&bar[XB_XCNT(b.x)], 1u);
    return b;
}
__device__ __forceinline__ void xcd_barrier_complete(unsigned* bar, unsigned x, unsigned& nloc, unsigned& nx) {
    const unsigned G = gridDim.x * gridDim.y * gridDim.z;
    unsigned sum, cnt, mine, sp = 0u;
    for (;;) {
        sum = 0u; cnt = 0u; mine = 0u;
#pragma unroll
        for (unsigned j = 0; j < 16; ++j) { const unsigned c = xb_ld(&bar[XB_XCNT(j)]); sum += c; cnt += (c > 0u) ? 1u : 0u; mine = (j == x) ? c : mine; }
        if (sum == G) break;
        __builtin_amdgcn_s_sleep(1);
        if ((++sp & 255u) == 0u) { if (xb_ld(&bar[XB_TMO])) break; if (sp > XB_SPIN_CAP) { atomicAdd(&bar[XB_TMO], 1u); break; } }
    }
    nloc = mine > 0u ? mine : 1u; nx = cnt > 0u ? cnt : 1u;
}

__device__ __forceinline__ void xcd_barrier(const XcdBarrier& b) {
    asm volatile("s_waitcnt vmcnt(0)" ::: "memory");
    __syncthreads();
    if (threadIdx.x == 0) {
        unsigned* bar = b.bar; asm volatile("" : "+s"(bar)); unsigned xq = b.x; asm volatile("" : "+s"(xq));
        __builtin_amdgcn_s_waitcnt(0);
        unsigned nloc = b.st[0], nx = b.st[1];
        if (nloc == 0u) { xcd_barrier_complete(bar, xq, nloc, nx); b.st[0] = nloc; b.st[1] = nx; }
        const unsigned old = xb_add(&bar[XB_XSUB(xq)], 1u);
        const unsigned gen = old / nloc;
        if (old + 1u == (gen + 1u) * nloc) {
            __builtin_amdgcn_fence(__ATOMIC_RELEASE, "agent");
            asm volatile("s_waitcnt vmcnt(0)" ::: "memory");
            const unsigned og = xb_add(&bar[XB_TOP], 1u);
            const unsigned tg = og / nx;
            if (og + 1u == (tg + 1u) * nx) xb_add(&bar[XB_TOPGEN], 1u);
            else XB_SPIN(xb_ld(&bar[XB_TOPGEN]) == tg, bar);
            __builtin_amdgcn_fence(__ATOMIC_ACQUIRE, "agent");
            xb_add(&bar[XB_XGEN(xq)], 1u);
            asm volatile("s_waitcnt vmcnt(0)" ::: "memory");
        } else {
            XB_SPIN(xb_ld(&bar[XB_XGEN(xq)]) == gen, bar);
            __builtin_amdgcn_fence(__ATOMIC_ACQUIRE, "agent");
            asm volatile("s_waitcnt vmcnt(0)" ::: "memory");
        }
    }
    __syncthreads();
}
#define ACC_T const pg8::f32x4 (&acc)[2][2][4][2]
#define FOR_AI_M _Pragma("unroll") for (int ai = 0; ai < 2; ++ai) _Pragma("unroll") for (int m = 0; m < 4; ++m)
__device__ __forceinline__ void sincos_rev(float turns, float& c, float& s) { const float t = __builtin_amdgcn_fractf(turns); c = __builtin_amdgcn_cosf(t); s = __builtin_amdgcn_sinf(t); }

struct EpiStore {
    bf16* O; int ldc;
    __device__ __forceinline__ void put(ACC_T, size_t row0, int col0, int wr, int wc, int fr, int fq, float sc) const {
        FOR_AI_M { bf16* rp = O + (row0 + 128 * ai + 64 * wr + 16 * m + fr) * (size_t)ldc + col0 + 32 * wc + 8 * fq;
#pragma unroll
            for (int bj = 0; bj < 2; ++bj) *(pg8::u32x4*)(rp + 128 * bj) = pg8::pack8(acc[ai][bj][m][0] * sc, acc[ai][bj][m][1] * sc); }
    }
};

struct EpiQK {
    bf16* QT; bf16* KT; bf16* PEX; bf16* KTT;
    __device__ __forceinline__ void operator()(ACC_T, const pg8::Unit& u, int wr, int wc, int fr, int fq) const {
        const bool isq = u.pn < 4; const int h = u.pn & 3; const float lg = log2gamma(h), gam = __builtin_amdgcn_exp2f(lg);
        float f2[2][4];
#pragma unroll
        for (int n = 0; n < 2; ++n)
#pragma unroll
            for (int i = 0; i < 4; ++i) f2[n][i] = __builtin_amdgcn_exp2f(-(float)(32 * wc + 8 * fq + 4 * n + i) * (L2THETA / 128.f)) * INV2PI;
        FOR_AI_M { const int s = u.pm * 256 + 128 * ai + 64 * wr + 16 * m + fr; const int cp = s & (RC - 1);
            const float dec = isq ? __builtin_amdgcn_exp2f((float)cp * lg) : __builtin_amdgcn_exp2f(-(float)cp * lg) * 0.0625f;
            pg8::f32x4 lo[2], hi[2];
#pragma unroll
            for (int n = 0; n < 2; ++n)
#pragma unroll
                for (int i = 0; i < 4; ++i) { float c, sn; sincos_rev((float)s * f2[n][i], c, sn); const float a = acc[ai][0][m][n][i], b = acc[ai][1][m][n][i];
                    lo[n][i] = (a * c - b * sn) * dec; hi[n][i] = (b * c + a * sn) * dec; }
            if (!isq) { bf16* dst = KT + (size_t)s * 1024 + h * 256 + 32 * wc + 8 * fq;
                *(pg8::u32x4*)dst = pg8::pack8(lo[0], lo[1]); *(pg8::u32x4*)(dst + 128) = pg8::pack8(hi[0], hi[1]); }
            if (isq) { bf16* px = PEX + ((size_t)h * SEQ + s) * PXP + RC + 32 * wc + 8 * fq;
                *(pg8::u32x4*)px = pg8::pack8(lo[0] * gam, lo[1] * gam); *(pg8::u32x4*)(px + 128) = pg8::pack8(hi[0] * gam, hi[1] * gam); }
            else { bf16* tp = KTT + (size_t)(h * 256 + 32 * wc + 8 * fq) * SEQ + s;
#pragma unroll
                for (int n = 0; n < 2; ++n)
#pragma unroll
                    for (int i = 0; i < 4; ++i) { tp[(size_t)(4 * n + i) * SEQ] = (bf16)f2bf(lo[n][i]); tp[(size_t)(128 + 4 * n + i) * SEQ] = (bf16)f2bf(hi[n][i]); } } }
    }
};
struct EpiKVT {
    bf16* VTE;
    __device__ __forceinline__ void operator()(ACC_T, const pg8::Unit& u, int wr, int wc, int fr, int fq) const {
        const int row0 = u.pm * 256;
        FOR_AI_M { const int r = row0 + 128 * ai + 64 * wr + 16 * m + fr;
#pragma unroll
            for (int bj = 0; bj < 2; ++bj) { const int s0 = u.pn * 256 + 128 * bj + 32 * wc + 8 * fq;
                *(pg8::u32x4*)(VTE + (size_t)r * VTP + (s0 >> 9) * PXP + (s0 & (RC - 1))) = pg8::pack8(acc[ai][bj][m][0], acc[ai][bj][m][1]); } }
    }
};
struct EpiKV {
    bf16* VTE;
    __device__ __forceinline__ void operator()(ACC_T, const pg8::Unit& u, int wr, int wc, int fr, int fq) const {
        const int et = u.pm & 1, hn = u.pm >> 1, n = hn % NCH, h = hn / NCH; const float sc = __builtin_amdgcn_exp2f((float)(RC - 1) * log2gamma(h));
        EpiStore st{VTE, VTP}; st.put(acc, (size_t)(h * 512 + 256 * et), n * PXP + RC, wr, wc, fr, fq, sc);
    }
};
struct EpiP {
    bf16* PEX;
    __device__ __forceinline__ void operator()(ACC_T, const pg8::Unit& u, int wr, int wc, int fr, int fq) const {
        const int x = u.pm % 3, hn = u.pm / 3, n = hn % NCH, h = hn / NCH, it = x > 0 ? 1 : 0, jt = x > 1 ? 1 : 0; const bool diag = (x != 1); const float ig = __builtin_amdgcn_exp2f(-log2gamma(h));
        FOR_AI_M { const int r = 128 * ai + 64 * wr + 16 * m + fr; bf16* rp = PEX + ((size_t)h * SEQ + n * RC + 256 * it + r) * PXP + 256 * jt + 32 * wc + 8 * fq;
#pragma unroll
            for (int bj = 0; bj < 2; ++bj) { pg8::f32x4 v[2];
#pragma unroll
                for (int nn = 0; nn < 2; ++nn)
#pragma unroll
                    for (int i = 0; i < 4; ++i) { const int c = 128 * bj + 32 * wc + 8 * fq + 4 * nn + i; const bool keep = !diag || (c <= r); v[nn][i] = keep ? acc[ai][bj][m][nn][i] * ig : 0.f; }
                *(pg8::u32x4*)(rp + 128 * bj) = pg8::pack8(v[0], v[1]);
                if (x == 0) *(pg8::u32x4*)(rp + 256 + 128 * bj) = (pg8::u32x4){0u, 0u, 0u, 0u}; } }
    }
};
struct EpiO {
    bf16* OG; float* SSP; int half;
    __device__ __forceinline__ void operator()(ACC_T, const pg8::Unit& u, int wr, int wc, int fr, int fq) const {
        const int it = u.pm & 1, hn = u.pm >> 1, n = hn % NCH, h = hn / NCH, et = u.pn;
        FOR_AI_M { const int s = n * RC + 256 * it + 128 * ai + 64 * wr + 16 * m + fr; bf16* rp = OG + ((size_t)half * SEQ + s) * 2048 + h * 512 + 256 * et + 32 * wc + 8 * fq;
            float ss = 0.f;
#pragma unroll
            for (int bj = 0; bj < 2; ++bj) { const pg8::f32x4 a = acc[ai][bj][m][0], b = acc[ai][bj][m][1];
                ss += (a[0] * a[0] + a[1] * a[1]) + (a[2] * a[2] + a[3] * a[3]) + (b[0] * b[0] + b[1] * b[1]) + (b[2] * b[2] + b[3] * b[3]);
                *(pg8::u32x4*)(rp + 128 * bj) = pg8::pack8(a, b); }
            ss += __shfl_xor(ss, 16); ss += __shfl_xor(ss, 32);
            if (fq == 0) SSP[((size_t)s * RH + h) * 8 + et * 4 + wc] = ss; }
    }
};
struct EpiGate {
    bf16* OG; const float* SSP; int half; unsigned char* OG8;
    __device__ __forceinline__ void operator()(ACC_T, const pg8::Unit& u, int wr, int wc, int fr, int fq) const {
        const int h = u.pn >> 1; float rs[2][4];
        FOR_AI_M { const int s = u.pm * 256 + 128 * ai + 64 * wr + 16 * m + fr; const f32x4 s0 = *(const f32x4*)(SSP + ((size_t)s * RH + h) * 8 + 4 * (fq & 1));
            float tot = (s0[0] + s0[1]) + (s0[2] + s0[3]); tot += __shfl_xor(tot, 16); rs[ai][m] = __builtin_amdgcn_rsqf(tot * (1.f / 512.f) + NORM_EPS); }
#pragma unroll
        for (int ai = 0; ai < 2; ++ai) { pg8::u32x4 ov[4][2];
#pragma unroll
            for (int m = 0; m < 4; ++m) { const bf16* rp = OG + ((size_t)half * SEQ + u.pm * 256 + 128 * ai + 64 * wr + 16 * m + fr) * 2048 + u.pn * 256 + 32 * wc + 8 * fq;
#pragma unroll
                for (int bj = 0; bj < 2; ++bj) ov[m][bj] = *(const pg8::u32x4*)(rp + 128 * bj); }
#pragma unroll
            for (int m = 0; m < 4; ++m) { unsigned char* rp = OG8 + ((size_t)half * SEQ + u.pm * 256 + 128 * ai + 64 * wr + 16 * m + fr) * 2048 + u.pn * 256 + 32 * wc + 8 * fq;
#pragma unroll
                for (int bj = 0; bj < 2; ++bj) { pg8::f32x4 v[2];
#pragma unroll
                    for (int nn = 0; nn < 2; ++nn)
#pragma unroll
                        for (int i = 0; i < 4; ++i) { const float gg = acc[ai][bj][m][nn][i]; const unsigned w = ov[m][bj][nn * 2 + (i >> 1)]; const float o = (i & 1) ? bfhi(w) : bflo(w);
                            v[nn][i] = gg * sigmoidf_(gg) * o * (rs[ai][m] * GSCI); }
                    *(unsigned long long*)(rp + 128 * bj) = (unsigned long long)attn_body::pk4_i8a(v[0][0], v[0][1], v[0][2], v[0][3]) | ((unsigned long long)attn_body::pk4_i8a(v[1][0], v[1][1], v[1][2], v[1][3]) << 32); } } }
    }
};
__device__ __forceinline__ unsigned pk4_fp8(float a, float b, float c, float d) { int w = 0; w = __builtin_amdgcn_cvt_pk_fp8_f32(a, b, w, false); w = __builtin_amdgcn_cvt_pk_fp8_f32(c, d, w, true); return (unsigned)w; }
__device__ __forceinline__ unsigned pk4_i8(float a, float b, float c, float d) {
    const unsigned u0 = __builtin_bit_cast(unsigned, __builtin_amdgcn_fmed3f(a, -127.f, 127.f) + 12582912.f), u1 = __builtin_bit_cast(unsigned, __builtin_amdgcn_fmed3f(b, -127.f, 127.f) + 12582912.f);
    const unsigned u2 = __builtin_bit_cast(unsigned, __builtin_amdgcn_fmed3f(c, -127.f, 127.f) + 12582912.f), u3 = __builtin_bit_cast(unsigned, __builtin_amdgcn_fmed3f(d, -127.f, 127.f) + 12582912.f);
    return __builtin_amdgcn_perm(u1, u0, 0x0c0c0400u) | __builtin_amdgcn_perm(u3, u2, 0x04000c0cu); }
template <bool X8, bool SRCF32> struct EpiResT {
    const void* src; bf16* dst; bf16* XBo; float* SSQ;
    __device__ __forceinline__ void operator()(ACC_T, const pg8::Unit& u, int wr, int wc, int fr, int fq) const {
#pragma unroll
        for (int ai = 0; ai < 2; ++ai) { f32x4 xo[SRCF32 ? 4 : 1][2][2]; pg8::u32x4 xr[SRCF32 ? 1 : 4][2];
#pragma unroll
            for (int m = 0; m < 4; ++m) { const size_t off = ((size_t)u.pm * 256 + 128 * ai + 64 * wr + 16 * m + fr) * DM + u.pn * 256 + 32 * wc + 8 * fq;
#pragma unroll
                for (int bj = 0; bj < 2; ++bj) { if constexpr (SRCF32) { xo[m][bj][0] = *(const f32x4*)((const float*)src + off + 128 * bj); xo[m][bj][1] = *(const f32x4*)((const float*)src + off + 128 * bj + 4); }
                    else xr[m][bj] = *(const pg8::u32x4*)((const bf16*)src + off + 128 * bj); } }
#pragma unroll
            for (int m = 0; m < 4; ++m) { const int row = u.pm * 256 + 128 * ai + 64 * wr + 16 * m + fr; const size_t off = (size_t)row * DM + u.pn * 256 + 32 * wc + 8 * fq; float ss = 0.f;
#pragma unroll
                for (int bj = 0; bj < 2; ++bj) { f32x4 o0, o1;
                    if constexpr (SRCF32) { o0 = xo[m][bj][0]; o1 = xo[m][bj][1]; }
                    else { const pg8::u32x4 r = xr[m][bj]; o0 = (f32x4){bflo(r[0]), bfhi(r[0]), bflo(r[1]), bfhi(r[1])}; o1 = (f32x4){bflo(r[2]), bfhi(r[2]), bflo(r[3]), bfhi(r[3])}; }
                    const f32x4 x0 = o0 + acc[ai][bj][m][0], x1 = o1 + acc[ai][bj][m][1];
                    *(pg8::u32x4*)(dst + off + 128 * bj) = pg8::pack8(x0, x1);
                    if (XBo) { if constexpr (X8) *(unsigned long long*)((unsigned char*)XBo + off + 128 * bj) = (unsigned long long)pk4_i8(x0[0] * XSCI, x0[1] * XSCI, x0[2] * XSCI, x0[3] * XSCI) | ((unsigned long long)pk4_i8(x1[0] * XSCI, x1[1] * XSCI, x1[2] * XSCI, x1[3] * XSCI) << 32);
                        else *(pg8::u32x4*)(XBo + off + 128 * bj) = pg8::pack8(x0, x1);
                        ss += (x0[0] * x0[0] + x0[1] * x0[1]) + (x0[2] * x0[2] + x0[3] * x0[3]) + (x1[0] * x1[0] + x1[1] * x1[1]) + (x1[2] * x1[2] + x1[3] * x1[3]); } }
                if (XBo) { ss += __shfl_xor(ss, 16); ss += __shfl_xor(ss, 32); if (fq == 0) SSQ[(size_t)row * 16 + u.pn * 4 + wc] = ss; } } }
    }
};

__device__ __forceinline__ float row_rs(const float* SSQ, int row, int fq) { const f32x4 a = *(const f32x4*)(SSQ + (size_t)row * 16 + 4 * fq);
    float t = (a[0] + a[1]) + (a[2] + a[3]); t += __shfl_xor(t, 16); t += __shfl_xor(t, 32); return __builtin_amdgcn_rsqf(t * (1.f / DM) + NORM_EPS); }
struct EpiSwiGLU {
    bf16* ACT; int ldc; const float* SSQ;
    __device__ __forceinline__ void operator()(ACC_T, const pg8::Unit& u, int wr, int wc, int fr, int fq) const {
        float rsv[2][4];
        FOR_AI_M { const int row = u.pm * 256 + 128 * ai + 64 * wr + 16 * m + fr; rsv[ai][m] = SSQ ? row_rs(SSQ, row, fq) : 1.f; }
        FOR_AI_M { const int row = u.pm * 256 + 128 * ai + 64 * wr + 16 * m + fr; const float rs = rsv[ai][m];
            bf16* rp = ACT + (size_t)row * ldc + u.pn * 128 + 32 * wc + 8 * fq; pg8::f32x4 v[2];
#pragma unroll
            for (int nn = 0; nn < 2; ++nn)
#pragma unroll
                for (int i = 0; i < 4; ++i) { const float gg = acc[ai][0][m][nn][i] * rs; v[nn][i] = gg * sigmoidf_(gg) * (acc[ai][1][m][nn][i] * rs); }
            *(pg8::u32x4*)rp = pg8::pack8(v[0], v[1]); }
    }
};
template <bool I8O> struct EpiSwiGLU8T {
    unsigned char* ACT; int ldc; float osc; const float* SSQ;
    __device__ __forceinline__ void operator()(ACC_T, const pg8::Unit& u, int wr, int wc, int fr, int fq) const {
        float rsv[2][4];
        FOR_AI_M { const int row = u.pm * 256 + 128 * ai + 64 * wr + 16 * m + fr; rsv[ai][m] = SSQ ? row_rs(SSQ, row, fq) : 1.f; }
        FOR_AI_M { const int row = u.pm * 256 + 128 * ai + 64 * wr + 16 * m + fr; const float rs = rsv[ai][m], rso = rs * osc;
            unsigned char* rp = ACT + (size_t)row * ldc + u.pn * 128 + 32 * wc + 8 * fq; pg8::f32x4 v[2];
#pragma unroll
            for (int nn = 0; nn < 2; ++nn)
#pragma unroll
                for (int i = 0; i < 4; ++i) { const float gg = acc[ai][0][m][nn][i] * rs; v[nn][i] = gg * sigmoidf_(gg) * (acc[ai][1][m][nn][i] * rso); }
            if constexpr (I8O) *(unsigned long long*)rp = (unsigned long long)pk4_i8(v[0][0], v[0][1], v[0][2], v[0][3]) | ((unsigned long long)pk4_i8(v[1][0], v[1][1], v[1][2], v[1][3]) << 32);
            else *(unsigned long long*)rp = (unsigned long long)pk4_fp8(v[0][0], v[0][1], v[0][2], v[0][3]) | ((unsigned long long)pk4_fp8(v[1][0], v[1][1], v[1][2], v[1][3]) << 32); }
    }
};
typedef EpiSwiGLU8T<false> EpiSwiGLU8;
struct EpiSwiGLUI {
    unsigned char* ACT; int ldc; float osc; const float* SSQ; float qs;
    __device__ __forceinline__ void operator()(ACC_T, const pg8::Unit& u, int wr, int wc, int fr, int fq) const {
        float rsv[2][4];
        FOR_AI_M { const int row = u.pm * 256 + 128 * ai + 64 * wr + 16 * m + fr; rsv[ai][m] = (SSQ ? row_rs(SSQ, row, fq) : 1.f) * qs; }
        FOR_AI_M { const int row = u.pm * 256 + 128 * ai + 64 * wr + 16 * m + fr; const float rs = rsv[ai][m], c1 = -1.4426950408889634f * rs, c2 = rs * rs * osc * (256.f / 32767.f);
            unsigned char* rp = ACT + (size_t)row * ldc + u.pn * 128 + 32 * wc + 8 * fq; float v[2][4];
#pragma unroll
            for (int nn = 0; nn < 2; ++nn)
#pragma unroll
                for (int i = 0; i < 4; ++i) { const float ga = acc[ai][0][m][nn][i], ua = acc[ai][1][m][nn][i]; const float g0 = (float)__builtin_bit_cast(int, ga), u0 = (float)__builtin_bit_cast(int, ua);
                    const float r = __builtin_amdgcn_rcpf(1.f + __builtin_amdgcn_exp2f(g0 * c1)); v[nn][i] = __builtin_fmaf((g0 * u0) * r, c2, 128.f / 32767.f); }
            unsigned w[2];
#pragma unroll
            for (int nn = 0; nn < 2; ++nn) { const unsigned d0 = __builtin_bit_cast(unsigned, __builtin_amdgcn_cvt_pknorm_i16(v[nn][0], v[nn][1])), d1 = __builtin_bit_cast(unsigned, __builtin_amdgcn_cvt_pknorm_i16(v[nn][2], v[nn][3]));
                w[nn] = __builtin_amdgcn_perm(d1, d0, 0x07050301u); }
            *(unsigned long long*)rp = (unsigned long long)w[0] | ((unsigned long long)w[1] << 32); }
    }
};
namespace pg8 { template <> struct epi_raw_i32<EpiSwiGLUI> { static constexpr bool value = true; }; }
struct EpiKVQ {
    bf16* K; bf16* V; bf16* Q; const float* SSQ; unsigned* NRM;
    __device__ __forceinline__ void operator()(ACC_T, const pg8::Unit& u, int wr, int wc, int fr, int fq) const {
        if (u.pn >= 4 && u.pn < 8) {
            float rsv[2][4];
            FOR_AI_M { rsv[ai][m] = row_rs(SSQ, u.pm * 256 + 128 * ai + 64 * wr + 16 * m + fr, fq); }
            FOR_AI_M { const int row = u.pm * 256 + 128 * ai + 64 * wr + 16 * m + fr; const float rs = rsv[ai][m]; bf16* rp = V + (size_t)row * 1024 + (u.pn - 4) * 256 + 32 * wc + 8 * fq;
#pragma unroll
                for (int bj = 0; bj < 2; ++bj) *(pg8::u32x4*)(rp + 128 * bj) = pg8::pack8(acc[ai][bj][m][0] * rs, acc[ai][bj][m][1] * rs); }
            return; }
        const bool isq = u.pn >= 8; const int ct = isq ? u.pn - 8 : u.pn; const float sc = isq ? C2Q : 1.f;
        float f2[2][4];
#pragma unroll
        for (int n = 0; n < 2; ++n)
#pragma unroll
            for (int i = 0; i < 4; ++i) f2[n][i] = __builtin_amdgcn_exp2f(-(float)(8 * fq + 4 * n + i) * (L2THETA / 32.f)) * INV2PI;
        float nmx = 0.f; float rsv[2][4];
        FOR_AI_M { rsv[ai][m] = row_rs(SSQ, u.pm * 256 + 128 * ai + 64 * wr + 16 * m + fr, fq); }
        FOR_AI_M { const int row = u.pm * 256 + 128 * ai + 64 * wr + 16 * m + fr; const int s = row & (SEQ - 1); const float rsc = rsv[ai][m] * sc;
            pg8::f32x4 lo[2], hi[2]; float ss = 0.f;
#pragma unroll
            for (int n = 0; n < 2; ++n)
#pragma unroll
                for (int i = 0; i < 4; ++i) { float c, sn; sincos_rev((float)s * f2[n][i], c, sn); const float a = acc[ai][0][m][n][i], b = acc[ai][1][m][n][i];
                    lo[n][i] = (a * c - b * sn) * rsc; hi[n][i] = (b * c + a * sn) * rsc; ss += lo[n][i] * lo[n][i] + hi[n][i] * hi[n][i]; }
            ss += __shfl_xor(ss, 16); ss += __shfl_xor(ss, 32); nmx = fmaxf(nmx, ss);
            bf16* dst = (isq ? Q : K) + (size_t)row * 1024 + ct * 256 + 64 * wc + 8 * fq;
            *(pg8::u32x4*)dst = pg8::pack8(lo[0], lo[1]); *(pg8::u32x4*)(dst + 32) = pg8::pack8(hi[0], hi[1]); }
        nmx = fmaxf(nmx, __shfl_xor(nmx, 1)); nmx = fmaxf(nmx, __shfl_xor(nmx, 2)); nmx = fmaxf(nmx, __shfl_xor(nmx, 4)); nmx = fmaxf(nmx, __shfl_xor(nmx, 8));
        nmx *= 1.02f;
        if (fr == 0 && fq == 0) (void)__hip_atomic_fetch_max(NRM + ((isq ? 2 : 0) + (u.pm * 256) / SEQ) * 16 + ct * 4 + wc, __builtin_bit_cast(unsigned, nmx), __ATOMIC_RELAXED, __HIP_MEMORY_SCOPE_AGENT);
    }
};
struct EpiMoeDown {
    unsigned char* Y; const float* slot_w; float wscale;
    __device__ __forceinline__ void operator()(ACC_T, const pg8::Unit& u, int wr, int wc, int fr, int fq) const {
        float wv[2][4];
        FOR_AI_M { wv[ai][m] = slot_w[u.pm * 256 + 128 * ai + 64 * wr + 16 * m + fr] * (wscale * YSCI); }
        FOR_AI_M { const float w = wv[ai][m]; unsigned char* rp = Y + (size_t)(u.pm * 256 + 128 * ai + 64 * wr + 16 * m + fr) * DM + u.pn * 256 + 32 * wc + 8 * fq;
#pragma unroll
            for (int bj = 0; bj < 2; ++bj) { const pg8::f32x4 v0 = acc[ai][bj][m][0] * w, v1 = acc[ai][bj][m][1] * w;
                *(unsigned long long*)(rp + 128 * bj) = (unsigned long long)pk4_i8(v0[0], v0[1], v0[2], v0[3]) | ((unsigned long long)pk4_i8(v1[0], v1[1], v1[2], v1[3]) << 32); } }
    }
};
struct EpiPart {
    bf16* PART;
    __device__ __forceinline__ void operator()(ACC_T, const pg8::Unit& u, int wr, int wc, int fr, int fq) const { EpiStore st{PART, 256}; st.put(acc, (size_t)u.pm * 256, 0, wr, wc, fr, fq, 1.f); }
};

struct SchedPlain {
    pg8::TileOrder ord; const char* A; const char* B; size_t sa, sb;
    __device__ __forceinline__ bool next(int i, pg8::Unit& u) const { int pm, pn; if (!ord.tile(i, pm, pn)) return false; u.pm = pm; u.pn = pn; u.a = A + pm * sa; u.b = B + pn * sb; return true; }
};
struct SchedKV {
    pg8::TileOrder ord; const char* VTE; const char* KTT;
    __device__ __forceinline__ bool next(int i, pg8::Unit& u) const { int pm, pn; if (!ord.tile(i, pm, pn)) return false; u.pm = pm; u.pn = pn; const int x = pm & 1, hn = pm >> 1, n = hn % NCH, h = hn / NCH;
        u.a = VTE + ((size_t)(h * 512 + 256 * x) * VTP + n * PXP) * 2; u.b = KTT + ((size_t)(h * 256) * SEQ + n * RC) * 2; return true; }
};
struct SchedP {
    pg8::TileOrder ord; const char* PEX; const char* KT;
    __device__ __forceinline__ bool next(int i, pg8::Unit& u) const { int pm, pn; if (!ord.tile(i, pm, pn)) return false; u.pm = pm; u.pn = pn; const int x = pm % 3, hn = pm / 3, n = hn % NCH, h = hn / NCH, it = x > 0 ? 1 : 0, jt = x > 1 ? 1 : 0;
        u.a = PEX + (((size_t)h * SEQ + n * RC + 256 * it) * PXP + RC) * 2; u.b = KT + ((size_t)(n * RC + 256 * jt) * 1024 + h * 256) * 2; return true; }
};
struct SchedO {
    pg8::TileOrder ord; const char* PEX; const char* VTE;
    __device__ __forceinline__ bool next(int i, pg8::Unit& u) const { int pm, pn; if (!ord.tile(i, pm, pn)) return false; u.pm = pm; u.pn = pn; const int it = pm & 1, hn = pm >> 1, n = hn % NCH, h = hn / NCH;
        u.a = PEX + ((size_t)h * SEQ + n * RC + 256 * it) * PXP * 2; u.b = VTE + ((size_t)(h * 512 + 256 * pn) * VTP + n * PXP) * 2; return true; }
};
struct SchedMoe {
    pg8::TileOrder ord; const char* A; const char* B; size_t sa, sb, se; const LAS int* seg; int lim;
    __device__ __forceinline__ int expert(int pm) const { int e = 0;
#pragma unroll
        for (int j = 1; j < NE; ++j) e += (pm >= seg[j]) ? 1 : 0;
        return __builtin_amdgcn_readfirstlane(e); }
    __device__ __forceinline__ bool next(int i, pg8::Unit& u) const { const long L = (long)i * ord.G + ord.c; if (L >= lim) return false; int pm, pn; ord.tileL((int)L, pm, pn); u.pm = pm; u.pn = pn;
        u.a = A + pm * sa; u.b = B + expert(pm) * se + pn * sb; return true; }
};
struct SchedMoeSplit {
    pg8::TileOrder ord; const char* A; const char* B; size_t sa, sb, se; const LAS int* seg; int first, nparts, s; size_t kb;
    __device__ __forceinline__ bool next(int i, pg8::Unit& u) const { const long J = (long)i * ord.G + ord.c; if (J >= nparts) return false; const int j = (int)J, un = first + j / s, part = j % s; int pm, pn; ord.tileL(un, pm, pn); u.pm = pm; u.pn = pn;
        int e = 0;
#pragma unroll
        for (int q = 1; q < NE; ++q) e += (pm >= seg[q]) ? 1 : 0;
        e = __builtin_amdgcn_readfirstlane(e);
        u.a = A + pm * sa + part * kb; u.b = B + e * se + pn * sb + part * kb; u.pm = j; return true; }
};
#ifndef WGM_MOEGU
#define WGM_MOEGU WGM_SET
#endif
#ifndef WGM_MOEDN
#define WGM_MOEDN 4
#endif
#ifndef WGM_DGU
#define WGM_DGU 4
#endif
#ifndef WGM_WOUT
#define WGM_WOUT WGM_SET
#endif
#ifndef WGM_KVQ
#define WGM_KVQ 2
#endif
#ifndef WGM_P1
#define WGM_P1 WGM_SET
#endif
#ifndef WGM_O
#define WGM_O 2
#endif
__device__ __forceinline__ float wave_sum(float v) {
#pragma unroll
    for (int o = 1; o < 64; o <<= 1) v += __shfl_xor(v, o);
    return v;
}
struct RmOff { int off; __device__ __forceinline__ int operator()(int n) const { return off + n; } };
struct RmGU { int up; __device__ __forceinline__ int operator()(int n) const { return 256 * (n >> 7) + 128 * up + (n & 127); } };
struct RmRope { int off; __device__ __forceinline__ int operator()(int n) const { const int w = n & 255; return off + (n & ~255) + 128 * ((w >> 5) & 1) + 32 * (w >> 6) + (w & 31); } };
template <class RM, bool I8 = false>
__device__ __forceinline__ void transpose_item(const float* W, int K, int N, bf16* WT, const float* gain, const RM rm, LAS float* scr, int item, int lane, float sc8 = 1.f) {
    const int nblk = N / 32, kb = item / nblk, nb = item % nblk, k0 = 64 * kb, n0 = 32 * nb;
    const int n4 = lane & 7, kr = lane >> 3;
    f32x4 v[8]; float gv[8];
#pragma unroll
    for (int j = 0; j < 8; ++j) v[j] = *(const GAS f32x4*)(W + (size_t)(k0 + 8 * j + kr) * N + n0 + 4 * n4);
#pragma unroll
    for (int j = 0; j < 8; ++j) gv[j] = gain ? gain[k0 + 8 * j + kr] : 1.f;
#pragma unroll
    for (int j = 0; j < 8; ++j) { LAS float* d = scr + (8 * j + kr) * 33 + 4 * n4; d[0] = v[j].x * gv[j]; d[1] = v[j].y * gv[j]; d[2] = v[j].z * gv[j]; d[3] = v[j].w * gv[j]; }
    LDS_WAIT(); asm volatile("" ::: "memory");
    const int c = lane & 7;
#pragma unroll
    for (int j = 0; j < 4; ++j) { const int n = (lane >> 3) + 8 * j; const LAS float* s = scr + (8 * c) * 33 + n;
        if constexpr (I8) *(GAS unsigned long long*)((unsigned char*)WT + (size_t)rm(n0 + n) * K + k0 + 8 * c) = (unsigned long long)pk4_i8(s[0 * 33] * sc8, s[1 * 33] * sc8, s[2 * 33] * sc8, s[3 * 33] * sc8) | ((unsigned long long)pk4_i8(s[4 * 33] * sc8, s[5 * 33] * sc8, s[6 * 33] * sc8, s[7 * 33] * sc8) << 32);
        else { v4u o; o.x = pk2(s[0 * 33], s[1 * 33]); o.y = pk2(s[2 * 33], s[3 * 33]); o.z = pk2(s[4 * 33], s[5 * 33]); o.w = pk2(s[6 * 33], s[7 * 33]);
            *(GAS v4u*)(WT + (size_t)rm(n0 + n) * K + k0 + 8 * c) = o; } }
    LDS_WAIT(); asm volatile("" ::: "memory");
}
struct TItem { const float* W; unsigned char* WT; const float* gain; int K, N, up, item; float sc; };
__device__ __forceinline__ void ti_load(const TItem& t, int lane, f32x4 (&v)[8], float (&gv)[8]) {
    const int nblk = t.N / 32, kb = t.item / nblk, nb = t.item % nblk, k0 = 64 * kb, n0 = 32 * nb, n4 = lane & 7, kr = lane >> 3;
#pragma unroll
    for (int j = 0; j < 8; ++j) v[j] = *(const GAS f32x4*)(t.W + (size_t)(k0 + 8 * j + kr) * t.N + n0 + 4 * n4);
#pragma unroll
    for (int j = 0; j < 8; ++j) gv[j] = t.gain ? t.gain[k0 + 8 * j + kr] : 1.f;
}
__device__ __forceinline__ void ti_store(const TItem& t, int lane, const f32x4 (&v)[8], const float (&gv)[8], LAS float* scr) {
    const int nblk = t.N / 32, kb = t.item / nblk, nb = t.item % nblk, k0 = 64 * kb, n0 = 32 * nb, n4 = lane & 7, kr = lane >> 3;
#pragma unroll
    for (int j = 0; j < 8; ++j) { LAS float* d = scr + (8 * j + kr) * 33 + 4 * n4; d[0] = v[j].x * gv[j]; d[1] = v[j].y * gv[j]; d[2] = v[j].z * gv[j]; d[3] = v[j].w * gv[j]; }
    LDS_WAIT(); asm volatile("" ::: "memory");
    const int c = lane & 7;
#pragma unroll
    for (int j = 0; j < 4; ++j) { const int n = n0 + (lane >> 3) + 8 * j; const LAS float* s = scr + (8 * c) * 33 + (lane >> 3) + 8 * j; const int row = t.up < 0 ? n : 256 * (n >> 7) + 128 * t.up + (n & 127);
        const float sc = t.sc;
        const float f0 = s[0 * 33] * sc, f1 = s[1 * 33] * sc, f2 = s[2 * 33] * sc, f3 = s[3 * 33] * sc, f4 = s[4 * 33] * sc, f5 = s[5 * 33] * sc, f6 = s[6 * 33] * sc, f7 = s[7 * 33] * sc;
        *(GAS unsigned long long*)(t.WT + (size_t)row * t.K + k0 + 8 * c) = (unsigned long long)pk4_i8(f0, f1, f2, f3) | ((unsigned long long)pk4_i8(f4, f5, f6, f7) << 32); }
    LDS_WAIT(); asm volatile("" ::: "memory");
}
__device__ __forceinline__ float rms_row_to_bf16(const float* xrow, bf16* orow, int lane, f32x4 (&v)[4]) {
    const GAS f32x4* xr = (const GAS f32x4*)xrow + lane; float s = 0.f;
#pragma unroll
    for (int j = 0; j < 4; ++j) { v[j] = xr[64 * j]; s += (v[j].x * v[j].x + v[j].y * v[j].y) + (v[j].z * v[j].z + v[j].w * v[j].w); }
    const float rs = __builtin_amdgcn_rsqf(wave_sum(s) * (1.f / DM) + NORM_EPS);
    GAS unsigned long long* o8 = (GAS unsigned long long*)orow + lane;
#pragma unroll
    for (int j = 0; j < 4; ++j) o8[64 * j] = (unsigned long long)pk2(v[j].x * rs, v[j].y * rs) | ((unsigned long long)pk2(v[j].z * rs, v[j].w * rs) << 32);
    return rs;
}

__device__ __forceinline__ void moe_split(int nmt, int G, int& U, int& full, int& rem, int& sp) {
    U = nmt * 4; full = (U / G) * G; rem = U - full; sp = 1;
    if (rem > 0) sp = (rem * 14 <= G) ? 14 : (rem * 7 <= G) ? 7 : (rem * 2 <= G) ? 2 : 1;
}
__device__ __forceinline__ void moe_reduce(const bf16* PART, unsigned char* Y, const int* slot_tok, const float* slot_w, int nmt, int G, int gw, int NGW, int lane, float wscale) {
    int U, full, rem, sp; moe_split(nmt, G, U, full, rem, sp);
    if (sp <= 1) return;
    pg8::TileOrder ord; ord.init(nmt, 4, G, 0, WGM_MOEDN);
    for (int it = gw; it < rem * 256; it += NGW) { const int ui = it >> 8, r = it & 255; int pm, pn; ord.tileL(full + ui, pm, pn);
        const int slot = pm * 256 + r, tok = slot_tok[slot]; if (tok < 0) continue;
        float a0 = 0.f, a1 = 0.f, a2 = 0.f, a3 = 0.f; unsigned long long pv[14];
#pragma unroll
        for (int p = 0; p < 14; ++p) pv[p] = *(const GAS unsigned long long*)(PART + ((size_t)(ui * sp + (p < sp ? p : sp - 1)) * 256 + r) * 256 + 4 * lane);
#pragma unroll
        for (int p = 0; p < 14; ++p) if (p < sp) { const unsigned long long v = pv[p];
            a0 += bflo((unsigned)v); a1 += bfhi((unsigned)v); a2 += bflo((unsigned)(v >> 32)); a3 += bfhi((unsigned)(v >> 32)); }
        const float w = slot_w[slot] * (wscale * YSCI); *((GAS unsigned*)(Y + (size_t)slot * DM + pn * 256) + lane) = pk4_i8(a0 * w, a1 * w, a2 * w, a3 * w); }
}

__device__ __forceinline__ void route_row(const f32x4 (&v)[4], int m, int t0, int lane, unsigned char* XB8, const float (&wr)[16][NE], LAS int* es, unsigned char* ws) {
    float s = 0.f;
#pragma unroll
    for (int j = 0; j < 4; ++j) s += (v[j].x * v[j].x + v[j].y * v[j].y) + (v[j].z * v[j].z + v[j].w * v[j].w);
    const float rs = __builtin_amdgcn_rsqf(wave_sum(s) * (1.f / DM) + NORM_EPS);
    GAS unsigned* o4 = (GAS unsigned*)(XB8 + (size_t)m * DM) + lane; const float r8 = rs * XSCI;
#pragma unroll
    for (int j = 0; j < 4; ++j) o4[64 * j] = pk4_i8(v[j].x * r8, v[j].y * r8, v[j].z * r8, v[j].w * r8);
    float lg[NE];
#pragma unroll
    for (int e = 0; e < NE; ++e) lg[e] = 0.f;
#pragma unroll
    for (int j = 0; j < 4; ++j)
#pragma unroll
        for (int i = 0; i < 4; ++i) { const float xv = v[j][i];
#pragma unroll
            for (int e = 0; e < NE; ++e) lg[e] += xv * wr[4 * j + i][e]; }
#pragma unroll
    for (int e = 0; e < NE; ++e) lg[e] = wave_sum(lg[e]) * rs;
    int e0 = 0; float m0 = lg[0];
#pragma unroll
    for (int e = 1; e < NE; ++e) if (lg[e] > m0) { m0 = lg[e]; e0 = e; }
    int e1 = -1; float m1 = 0.f;
#pragma unroll
    for (int e = 0; e < NE; ++e) if (e != e0 && (e1 < 0 || lg[e] > m1)) { m1 = lg[e]; e1 = e; }
    const float w1v = 1.f / (1.f + __expf(m0 - m1)), w0v = 1.f - w1v;
    if (lane == 0) { ((int*)(ws + WS_TOKE))[m] = e0 | (e1 << 8); ((float*)(ws + WS_TOKW))[2 * m] = w0v; ((float*)(ws + WS_TOKW))[2 * m + 1] = w1v; es[2 * (m - t0)] = e0; es[2 * (m - t0) + 1] = e1; }
}

enum { IN_X = 0, IN_ANG, IN_FNG, IN_RWIN, IN_RWOUT, IN_KVNG, IN_WKV, IN_WQ, IN_LQ1, IN_LK1, IN_LQ2, IN_LK2, IN_SUBG, IN_WO, IN_FG, IN_FU, IN_FD, IN_MR, IN_MG, IN_MU, IN_MD, IN_FING, N_IN };
struct Args { const float* in[N_IN]; float* out; unsigned char* ws; int ph_lo, ph_hi; };
constexpr int N_PHASES = 22;
#ifndef ALIGN_E
#define ALIGN_E true
#endif
#ifndef REP_MASK
#define REP_MASK 0u
#endif
#define REPC(c) (1 + (int)(((REP_MASK) >> (c)) & 1u))

__global__ void __launch_bounds__(NWAVES * 64, 2) yoco_fwd(Args args) {
    extern __shared__ __attribute__((aligned(16))) unsigned char lds[];
    LAS unsigned char* L = (LAS unsigned char*)lds;
    volatile LAS unsigned* MISC = (volatile LAS unsigned*)(L + MISC_OFF);
    LAS int* SEG = (LAS int*)(L + SEG_OFF);
    LAS unsigned short* IDXC = (LAS unsigned short*)(L + IDXC_OFF);
    const int tid0 = threadIdx.x, wave = __builtin_amdgcn_readfirstlane(tid0 >> 6);
#define FRESH_TID int tid = threadIdx.x; asm volatile("" : "+v"(tid)); const int lane = tid & 63; (void)lane
    const int G = gridDim.x, bx = blockIdx.x; const int vcu = (G % 8 == 0) ? (bx % 8) * (G / 8) + bx / 8 : bx;
    unsigned char* ws = args.ws;
    gu32* ctl = (gu32*)(ws + WS_CTL);
    float* const X = args.out;
    bf16* const XR = (bf16*)(ws + WS_XR);
    for (int u = tid0; u < (IDXC_OFF - MISC_OFF) / 4; u += NWAVES * 64) ((LAS unsigned*)(L + MISC_OFF))[u] = 0u;
    __syncthreads();
    XcdBarrier bar = xcd_barrier_post((unsigned*)(ctl + CW_BAR), MISC + 8);
    const int lo = args.ph_lo, hi = args.ph_hi;
#ifndef PH_MASK
#define PH_MASK 0xffffffffu
#endif
#define CLS(c) (((PH_MASK) >> (c)) & 1u)
#define IN(k) (lo <= (k) && (k) < hi)
#define SEAM(k) do { if (IN(k) && IN((k) + 1)) xcd_barrier(bar); } while (0)
    const int gw = vcu * NWAVES + wave, NGW = G * NWAVES;
    bf16* const XB = (bf16*)(ws + WS_XB);

    if (CLS(0) && IN(0)) for (int rep_ = 0; rep_ < REPC(0); ++rep_) { FRESH_TID;
        LAS float* scr = (LAS float*)(L + RING_OFF + wave * 16384);
        const float* g0 = args.in[IN_ANG]; const float* g1 = args.in[IN_ANG] + DM; const float* f0 = args.in[IN_FNG];
        constexpr int I_WIN = 16 * 192, I_WOUT = 32 * 32, I_G = 16 * 88, I_D = 44 * 32, I_KV = 16 * 64, I_Q = 16 * 32, I_O = 16 * 32;
        constexpr int NIT = I_WIN + I_WOUT + 2 * I_G + I_D + I_KV + I_Q + I_O;
        int it = gw;
        for (int m = gw; m < TOK || it < NIT; m += 2 * NGW) { const bool hr = m < TOK; const int mm = hr ? m : 0;
            const int m2 = mm + NGW; const bool has2 = hr && m2 < TOK; const float* xin = args.in[IN_X];
            const GAS f32x4* xa = (const GAS f32x4*)(xin + (size_t)mm * DM) + lane; const GAS f32x4* xb = (const GAS f32x4*)(xin + (size_t)(has2 ? m2 : mm) * DM) + lane; f32x4 va[4], vb[4]; float sa = 0.f, sb = 0.f;
#pragma unroll
            for (int j = 0; j < 4; ++j) va[j] = xa[64 * j];
#pragma unroll
            for (int j = 0; j < 4; ++j) vb[j] = xb[64 * j];
            if (it < NIT) { do {
            int r = it;
            if (r < I_WIN) {
                if (r % 192 < 64) transpose_item<RmOff, true>(args.in[IN_RWIN], 1024, 6144, (bf16*)(ws + WS_WIN), g0, RmOff{0}, scr, r, lane, WSCI);
                else transpose_item<RmOff, true>(args.in[IN_RWIN], 1024, 6144, (bf16*)(ws + WS_WIN + 4 * MiB), g0, RmOff{-2048}, scr, r, lane, WSCI);
                break; } r -= I_WIN;
            if (r < I_WOUT) { transpose_item<RmOff, true>(args.in[IN_RWOUT], 2048, 1024, (bf16*)(ws + WS_WOUT), (const float*)nullptr, RmOff{0}, scr, r, lane, WOUTSCI); break; } r -= I_WOUT;
            if (r < I_G) { transpose_item<RmGU, true>(args.in[IN_FG], 1024, DFF, (bf16*)(ws + WS_WGU), f0, RmGU{0}, scr, r, lane, WSCI); break; } r -= I_G;
            if (r < I_G) { transpose_item<RmGU, true>(args.in[IN_FU], 1024, DFF, (bf16*)(ws + WS_WGU), f0, RmGU{1}, scr, r, lane, WSCI); break; } r -= I_G;
            if (r < I_D) { transpose_item<RmOff, true>(args.in[IN_FD], DFF, 1024, (bf16*)(ws + WS_WD), (const float*)nullptr, RmOff{0}, scr, r, lane, WDSCI_D); break; } r -= I_D;
            if (r < I_KV) {
                const int nblk = 64, nb = r % nblk;
                if (nb < 32) transpose_item<RmRope, true>(args.in[IN_WKV], 1024, 2048, (bf16*)(ws + WS_WKVQ), args.in[IN_KVNG], RmRope{0}, scr, r, lane, WSCI);
                else transpose_item<RmOff, true>(args.in[IN_WKV], 1024, 2048, (bf16*)(ws + WS_WKVQ), args.in[IN_KVNG], RmOff{0}, scr, r, lane, WSCI);
                break; } r -= I_KV;
            if (r < I_Q) { transpose_item<RmRope, true>(args.in[IN_WQ], 1024, 1024, (bf16*)(ws + WS_WKVQ), g1, RmRope{2048}, scr, r, lane, WSCI); break; } r -= I_Q;
            transpose_item<RmOff, true>(args.in[IN_WO], 1024, 1024, (bf16*)(ws + WS_WO), (const float*)nullptr, RmOff{0}, scr, r, lane, WOSCI);
                    } while (0); it += NGW; }
            if (!hr) continue;
#pragma unroll
            for (int j = 0; j < 4; ++j) { sa += (va[j].x * va[j].x + va[j].y * va[j].y) + (va[j].z * va[j].z + va[j].w * va[j].w); sb += (vb[j].x * vb[j].x + vb[j].y * vb[j].y) + (vb[j].z * vb[j].z + vb[j].w * vb[j].w); }
            const float ra = __builtin_amdgcn_rsqf(wave_sum(sa) * (1.f / DM) + NORM_EPS), rb = __builtin_amdgcn_rsqf(wave_sum(sb) * (1.f / DM) + NORM_EPS);
            GAS unsigned* ia = (GAS unsigned*)((unsigned char*)X + (size_t)mm * DM) + lane; GAS unsigned* ib = (GAS unsigned*)((unsigned char*)X + (size_t)(has2 ? m2 : mm) * DM) + lane;
#pragma unroll
            for (int j = 0; j < 4; ++j) { const float ri = ra * XSCI; ia[64 * j] = pk4_i8(va[j].x * ri, va[j].y * ri, va[j].z * ri, va[j].w * ri); }
            if (has2) {
#pragma unroll
                for (int j = 0; j < 4; ++j) { const float ri = rb * XSCI; ib[64 * j] = pk4_i8(vb[j].x * ri, vb[j].y * ri, vb[j].z * ri, vb[j].w * ri); } } }
    }
    SEAM(0);

    for (int hh = 0; hh < 3; ++hh) {
        const int p0 = 1 + 4 * hh;
        bf16* const QT = (bf16*)(ws + WS_QT); bf16* const KT = (bf16*)(ws + WS_KT); bf16* const KTT = (bf16*)(ws + WS_KTT); bf16* const VTE = (bf16*)(ws + WS_VTE); bf16* const PEX = (bf16*)(ws + WS_PEX);
        bf16* const OG = (bf16*)(ws + WS_OG); float* const SSP = (float*)(ws + WS_SSP);
        if (CLS(6) && IN(p0) && hh > 0) {
            const int half = hh - 1; const char* xih = (const char*)X + (size_t)half * SEQ * DM;
            SchedPlain S; S.ord.init(SEQ / 256, 8, G, bx); S.A = xih; S.B = (const char*)(ws + WS_WIN + 4 * MiB) + (size_t)2048 * DM; S.sa = (size_t)256 * DM; S.sb = (size_t)256 * DM;
            EpiGate E{OG, SSP, half, (unsigned char*)X + (size_t)32 * MiB};
            pg8::gemm_phase<EpiGate, SchedPlain, ALIGN_E, false, false, true>(L + RING_OFF, pg8::Shape{DM / 2, DM / 2, DM / 128, 0, 0, 1.f / (XSCI * WSCI)}, S, E);
        }
        const int half = hh;
        const char* xbh = (const char*)(XB + (size_t)half * SEQ * DM);
        if (CLS(1) && IN(p0) && hh < 2) for (int rep_ = 0; rep_ < REPC(1); ++rep_) {
            {
                SchedPlain S; S.ord.init(SEQ / 256, 8, G, bx, WGM_P1); S.A = (const char*)X + (size_t)half * SEQ * DM; S.B = (const char*)(ws + WS_WIN); S.sa = (size_t)256 * DM; S.sb = (size_t)256 * DM;
                EpiQK E{QT, KT, PEX, KTT};
                pg8::gemm_phase<EpiQK, SchedPlain, ALIGN_E, false, false, true>(L + RING_OFF, pg8::Shape{DM / 2, DM / 2, DM / 128, 0, 0, 1.f / (XSCI * WSCI)}, S, E);
            }
            {
                SchedPlain S; S.ord.init(8, SEQ / 256, G, bx, WGM_P1); S.A = (const char*)(ws + WS_WIN + 4 * MiB); S.B = (const char*)X + (size_t)half * SEQ * DM; S.sa = (size_t)256 * DM; S.sb = (size_t)256 * DM;
                EpiKVT E{VTE};
                pg8::gemm_phase<EpiKVT, SchedPlain, ALIGN_E, false, false, true>(L + RING_OFF, pg8::Shape{DM / 2, DM / 2, DM / 128, 0, 0, 1.f / (XSCI * WSCI)}, S, E);
            }
        }
        SEAM(p0);
        if (hh == 2) break;
        if (CLS(2) && IN(p0 + 1)) for (int rep_ = 0; rep_ < REPC(2); ++rep_) {
            SchedKV S; S.ord.init(RH * NCH * 2, 1, G, bx); S.VTE = (const char*)VTE; S.KTT = (const char*)KTT;
            EpiKV E{VTE};
            pg8::gemm_phase<EpiKV, SchedKV, ALIGN_E, false>(L + RING_OFF, pg8::Shape{VTP, SEQ, RC / 64}, S, E);
        }
        if (CLS(4) && IN(p0 + 1)) for (int rep_ = 0; rep_ < REPC(4); ++rep_) {
            SchedP S; S.ord.init(RH * NCH * 3, 1, G, bx); S.PEX = (const char*)PEX; S.KT = (const char*)KT;
            EpiP E{PEX};
            pg8::gemm_phase<EpiP, SchedP, ALIGN_E, false>(L + RING_OFF, pg8::Shape{PXP, DM, 256 / 64}, S, E);
        }
        SEAM(p0 + 1);
        if (CLS(3) && IN(p0 + 2)) { FRESH_TID;
            const int gt = vcu * (NWAVES * 64) + tid, NGT = G * NWAVES * 64;
            for (int w = gt; w < RH * 512 * 64; w += NGT) {
                const int d4 = w & 63, e = (w >> 6) & 511, h = w >> 15; const float gC = __builtin_amdgcn_exp2f((float)RC * log2gamma(h));
                bf16* p = VTE + (size_t)(h * 512 + e) * VTP + RC + 4 * d4;
                float r0 = 0.f, r1 = 0.f, r2 = 0.f, r3 = 0.f;
                for (int n0 = 0; n0 < NCH; n0 += 16) {
                    unsigned long long t[16];
#pragma unroll
                    for (int j = 0; j < 16; ++j) t[j] = *(const GAS unsigned long long*)(p + (size_t)(n0 + j) * PXP);
#pragma unroll
                    for (int j = 0; j < 16; ++j) { *(GAS unsigned long long*)(p + (size_t)(n0 + j) * PXP) = (unsigned long long)pk2(r0, r1) | ((unsigned long long)pk2(r2, r3) << 32);
                        const unsigned lo = (unsigned)t[j], hi = (unsigned)(t[j] >> 32);
                        r0 = r0 * gC + bflo(lo); r1 = r1 * gC + bfhi(lo); r2 = r2 * gC + bflo(hi); r3 = r3 * gC + bfhi(hi); }
                }
            }
        }
        SEAM(p0 + 2);
        if (CLS(5) && IN(p0 + 3)) for (int rep_ = 0; rep_ < REPC(5); ++rep_) {
            SchedO S; S.ord.init(RH * NCH * 2, 2, G, bx, WGM_O); S.PEX = (const char*)PEX; S.VTE = (const char*)VTE;
            EpiO E{OG, SSP, half};
            pg8::gemm_phase<EpiO, SchedO, ALIGN_E, false>(L + RING_OFF, pg8::Shape{PXP, VTP, PXP / 64}, S, E);
        }
        SEAM(p0 + 3);
    }

    if (CLS(7) && IN(10)) for (int rep_ = 0; rep_ < REPC(7); ++rep_) {
        SchedPlain S; S.ord.init(TOK / 256, 4, G, bx, WGM_WOUT); S.A = (const char*)X + (size_t)32 * MiB; S.B = (const char*)(ws + WS_WOUT); S.sa = (size_t)256 * 2048; S.sb = (size_t)256 * 2048;
        EpiResT<true, true> E{args.in[IN_X], XR, XB, (float*)(ws + WS_SSP)};
        pg8::gemm_phase<EpiResT<true, true>, SchedPlain, ALIGN_E, false, false, true>(L + RING_OFF, pg8::Shape{2048 / 2, 2048 / 2, 2048 / 128, 0, 0, 1.f / (GSCI * WOUTSCI)}, S, E);
    }
    SEAM(10);
    if (CLS(9) && IN(11)) for (int rep_ = 0; rep_ < REPC(9); ++rep_) {
        SchedPlain S; S.ord.init(TOK / 256, DFF / 128, G, bx, WGM_DGU); S.A = (const char*)XB; S.B = (const char*)(ws + WS_WGU); S.sa = (size_t)256 * DM; S.sb = (size_t)256 * DM;
        EpiSwiGLUI E{ws + WS_ACT, DFF, ASCI, (const float*)(ws + WS_SSP), 1.f / (XSCI * WSCI)};
        pg8::gemm_phase<EpiSwiGLUI, SchedPlain, ALIGN_E, false, false, true>(L + RING_OFF, pg8::Shape{DM / 2, DM / 2, DM / 128, 0, 0, 1.f / (XSCI * WSCI)}, S, E);
    }
    SEAM(11);
    if (CLS(10) && IN(12)) {
        SchedPlain S; S.ord.init(TOK / 256, 4, G, bx); S.A = (const char*)(ws + WS_ACT); S.B = (const char*)(ws + WS_WD); S.sa = (size_t)256 * DFF; S.sb = (size_t)256 * DFF;
        EpiResT<true, false> E{XR, XR, XB, (float*)(ws + WS_SSP)};
        pg8::gemm_phase<EpiResT<true, false>, SchedPlain, ALIGN_E, false, false, true>(L + RING_OFF, pg8::Shape{DFF / 2, DFF / 2, DFF / 128, 0, 0, 1.f / (ASCI * WDSCI_D)}, S, E);
    }
    SEAM(12);
    if (CLS(12) && IN(13)) for (int rep_ = 0; rep_ < REPC(12); ++rep_) {
        SchedPlain S; S.ord.init(TOK / 256, 12, G, bx, WGM_KVQ); S.A = (const char*)XB; S.B = (const char*)(ws + WS_WKVQ); S.sa = (size_t)256 * DM; S.sb = (size_t)256 * DM;
        EpiKVQ E{(bf16*)(ws + WS_K), (bf16*)(ws + WS_V), (bf16*)(ws + WS_Q), (const float*)(ws + WS_SSP), (unsigned*)(ctl + CW_NRM)};
        pg8::gemm_phase<EpiKVQ, SchedPlain, ALIGN_E, false, false, true>(L + RING_OFF, pg8::Shape{DM / 2, DM / 2, DM / 128, 0, 0, 1.f / (XSCI * WSCI)}, S, E);
    }
    SEAM(13);
    if (CLS(13) && IN(14)) {
        float lam; { const int ln_ = threadIdx.x & 63; const float l1 = args.in[IN_LQ1][ln_] * args.in[IN_LK1][ln_], l2 = args.in[IN_LQ2][ln_] * args.in[IN_LK2][ln_]; lam = __expf(wave_sum(l1)) - __expf(wave_sum(l2)) + LAMBDA_INIT; }
        for (int rep_ = 0; rep_ < REPC(13); ++rep_)
        attn_body::attn_phase<8>((char*)lds + RING_OFF, (const attn_body::bf16*)(ws + WS_Q), (const attn_body::bf16*)(ws + WS_K), (const attn_body::bf16*)(ws + WS_V),
                                 (attn_body::bf16*)(ws + WS_O0), (attn_body::bf16*)(ws + WS_O1), (attn_body::bf16*)(ws + WS_OB8), (const unsigned*)(ctl + CW_NRM), lam, args.in[IN_SUBG], (1.f - LAMBDA_INIT) * OSCI, SUBLN_EPS, vcu, G);
    }
    SEAM(14);
    if (CLS(15) && IN(15)) {
        SchedPlain S; S.ord.init(TOK / 256, 4, G, bx); S.A = (const char*)(ws + WS_OB8); S.B = (const char*)(ws + WS_WO); S.sa = (size_t)256 * DM; S.sb = (size_t)256 * DM;
        EpiResT<false, false> E{XR, XR, (bf16*)nullptr, (float*)nullptr};
        pg8::gemm_phase<EpiResT<false, false>, SchedPlain, ALIGN_E, false, false, true>(L + RING_OFF, pg8::Shape{DM / 2, DM / 2, DM / 128, 0, 0, 1.f / (OSCI * WOSCI)}, S, E);
    }
    SEAM(15);
    const int TPB = (TOK + G - 1) / G;
    if (CLS(16) && IN(16)) for (int rep_ = 0; rep_ < REPC(16); ++rep_) { FRESH_TID;
        LAS int* es = (LAS int*)(L + RING_OFF + 12288);
        LAS int* rk = es + 512;
        const float* f1 = args.in[IN_FNG] + DM;
        float wr[16][NE];
#pragma unroll
        for (int j = 0; j < 4; ++j)
#pragma unroll
            for (int i = 0; i < 4; ++i) { const int kk = 256 * j + 4 * lane + i; const GAS f32x4* wp = (const GAS f32x4*)(args.in[IN_MR] + (size_t)kk * NE); const f32x4 w0 = wp[0], w1 = wp[1]; const float gk = f1[kk];
                wr[4 * j + i][0] = w0[0] * gk; wr[4 * j + i][1] = w0[1] * gk; wr[4 * j + i][2] = w0[2] * gk; wr[4 * j + i][3] = w0[3] * gk; wr[4 * j + i][4] = w1[0] * gk; wr[4 * j + i][5] = w1[1] * gk; wr[4 * j + i][6] = w1[2] * gk; wr[4 * j + i][7] = w1[3] * gk; }
        __syncthreads();
        const int t0 = bx * TPB, t1 = (t0 + TPB < TOK) ? t0 + TPB : TOK;
        LAS float* scr = (LAS float*)(L + RING_OFF + wave * 16384);
        constexpr int I_E = 16 * 112, NIT_ = NE * 3 * I_E;
#define MOE_ITEM(t_, it_) do { const int e_ = (it_) / (3 * I_E), r_ = (it_) % (3 * I_E), wh_ = r_ / I_E; (t_).item = r_ % I_E; \
                if (wh_ < 2) { (t_).W = (wh_ ? args.in[IN_MU] : args.in[IN_MG]) + (size_t)e_ * 1024 * DFE; (t_).WT = (ws + WS_WMGU) + (size_t)e_ * 7168 * 1024; (t_).gain = f1; (t_).K = 1024; (t_).N = DFE; (t_).up = wh_; (t_).sc = WSCI; } \
                else { (t_).W = args.in[IN_MD] + (size_t)e_ * DFE * 1024; (t_).WT = (ws + WS_WMD) + (size_t)e_ * 1024 * DFE; (t_).gain = nullptr; (t_).K = DFE; (t_).N = 1024; (t_).up = -1; (t_).sc = WDSCI_M; } } while (0)
        int it = gw;
        for (int m = t0 + wave; m < t1; m += 2 * NWAVES) {
            const int m2 = m + NWAVES; const bool has2 = m2 < t1;
            f32x4 va[4], vb[4];
            unsigned long long ra_[4], rb_[4];
            { const GAS unsigned long long* xa = (const GAS unsigned long long*)(XR + (size_t)m * DM) + lane; const GAS unsigned long long* xb = (const GAS unsigned long long*)(XR + (size_t)(has2 ? m2 : m) * DM) + lane;
#pragma unroll
              for (int j = 0; j < 4; ++j) ra_[j] = xa[64 * j];
#pragma unroll
              for (int j = 0; j < 4; ++j) rb_[j] = xb[64 * j]; }
            for (int c = 0; c < 2 && it < NIT_; ++c, it += NGW) { TItem tc; f32x4 vc[8]; float gc[8]; MOE_ITEM(tc, it); ti_load(tc, lane, vc, gc); ti_store(tc, lane, vc, gc, scr); }
#pragma unroll
            for (int j = 0; j < 4; ++j) { va[j] = (f32x4){bflo((unsigned)ra_[j]), bfhi((unsigned)ra_[j]), bflo((unsigned)(ra_[j] >> 32)), bfhi((unsigned)(ra_[j] >> 32))}; vb[j] = (f32x4){bflo((unsigned)rb_[j]), bfhi((unsigned)rb_[j]), bflo((unsigned)(rb_[j] >> 32)), bfhi((unsigned)(rb_[j] >> 32))}; }
            route_row(va, m, t0, lane, (unsigned char*)XB, wr, es, ws);
            if (has2) route_row(vb, m2, t0, lane, (unsigned char*)XB, wr, es, ws);
        }
        __syncthreads();
        if (wave == 0) {
            int cnt[2][NE];
#pragma unroll
            for (int k = 0; k < 2; ++k)
#pragma unroll
                for (int e = 0; e < NE; ++e) cnt[k][e] = 0;
            const int nt_ = t1 - t0;
            for (int r0 = 0; r0 < nt_; r0 += 64) { const int li = r0 + lane; const bool ok = li < nt_;
#pragma unroll
                for (int k = 0; k < 2; ++k) { const int ek = ok ? es[2 * li + k] : -1; int myr = 0;
#pragma unroll
                    for (int e = 0; e < NE; ++e) { const unsigned long long mk = __ballot(ek == e); if (ek == e) myr = cnt[k][e] + __popcll(mk & ((1ull << lane) - 1ull)); cnt[k][e] += __popcll(mk); }
                    if (ok) rk[2 * li + k] = myr; } }
            LDS_WAIT();
            for (int li = lane; li < nt_; li += 64) ((int*)(ws + WS_TOKR))[t0 + li] = rk[2 * li] | (rk[2 * li + 1] << 16);
            if (lane < 16) { int c = 0;
#pragma unroll
                for (int k = 0; k < 2; ++k)
#pragma unroll
                    for (int e = 0; e < NE; ++e) if (lane == k * NE + e) c = cnt[k][e];
                ((int*)(ws + WS_HIST))[bx * 16 + lane] = c; }
        }
        if (it < NIT_) { TItem ta; f32x4 va[8]; float ga[8]; MOE_ITEM(ta, it); ti_load(ta, lane, va, ga);
            for (;;) { const int nit = it + NGW; TItem tb = ta; f32x4 vb[8]; float gb[8];
                if (nit < NIT_) { MOE_ITEM(tb, nit); ti_load(tb, lane, vb, gb); }
                ti_store(ta, lane, va, ga, scr);
                if (nit >= NIT_) break;
                ta = tb; it = nit;
#pragma unroll
                for (int j = 0; j < 8; ++j) { va[j] = vb[j]; ga[j] = gb[j]; } } }
#undef MOE_ITEM
    }
    SEAM(16);
    if (IN(17) || IN(18) || IN(19) || IN(20)) { FRESH_TID;
        LAS int* tot = (LAS int*)(L + RING_OFF);
        if (tid < 32) tot[tid] = 0;
        if (tid >= 32 && tid < 40) tot[tid] = ((const int*)(ws + WS_HIST))[bx * 16 + (tid - 32)];
        __syncthreads();
        { const int c = tid & 15; int t = 0, mine = 0; const int* hist = (const int*)(ws + WS_HIST);
#pragma unroll
            for (int j = 0; j < 8; ++j) { const int b = (tid >> 4) + 32 * j; if (b < G) { const int v = hist[b * 16 + c]; if (b < bx) mine += v; t += v; } }
            for (int b = (tid >> 4) + 256; b < G; b += 32) { const int v = hist[b * 16 + c]; if (b < bx) mine += v; t += v; }
            atomicAdd((int*)&tot[c], t); atomicAdd((int*)&tot[16 + c], mine); }
        __syncthreads();
        if (tid < 1) { int acc_ = 0; for (int e = 0; e < NE; ++e) { SEG[e] = acc_; acc_ += (tot[e] + tot[NE + e] + 255) >> 8; } SEG[NE] = acc_; }
        __syncthreads();
    }
    if (CLS(17) && IN(17)) { FRESH_TID;
        LAS int* tot = (LAS int*)(L + RING_OFF);
        int* slot_tok = (int*)(ws + WS_SLOTT); float* slot_w = (float*)(ws + WS_SLOTW);
        const int t0 = bx * TPB, t1 = (t0 + TPB < TOK) ? t0 + TPB : TOK;
        for (int m = t0 + tid; m < t1; m += NWAVES * 64) { const int ee = ((const int*)(ws + WS_TOKE))[m], rr = ((const int*)(ws + WS_TOKR))[m];
#pragma unroll
            for (int k = 0; k < 2; ++k) { const int e = (ee >> (8 * k)) & 255, r = (rr >> (16 * k)) & 0xffff; const int slot = SEG[e] * 256 + tot[16 + e] + tot[16 + NE + e] + (k ? tot[32 + e] + r : r);
                slot_tok[slot] = m; slot_w[slot] = ((const float*)(ws + WS_TOKW))[2 * m + k]; ((int*)(ws + WS_TOKS))[2 * m + k] = slot; } }
        if (bx < NE) { const int e = bx; const int beg = SEG[e] * 256 + tot[e] + tot[NE + e], end = SEG[e + 1] * 256;
            for (int s = beg + tid; s < end; s += NWAVES * 64) { slot_tok[s] = -1; slot_w[s] = 0.f; } }
        __syncthreads();
    }
    SEAM(17);
    {
        const int pg = 18;
        const int* slot_tok = (const int*)(ws + WS_SLOTT); const float* slot_w = (const float*)(ws + WS_SLOTW);
        const int nmt = __builtin_amdgcn_readfirstlane(SEG[NE]);
        if (CLS(18) && IN(pg)) for (int rep_ = 0; rep_ < REPC(18); ++rep_) { FRESH_TID;
            SchedMoe S; S.ord.init(nmt, DFE / 128, G, bx, WGM_MOEGU); S.A = (const char*)XB; S.B = (const char*)(ws + WS_WMGU); S.sa = 0; S.sb = (size_t)256 * DM; S.se = (size_t)7168 * DM; S.seg = SEG; S.lim = S.ord.nwg;
            {
                pg8::Unit u;
                for (int i = wave; i < IDXC_UNITS && S.next(i, u); i += NWAVES) { const int* sp = slot_tok + u.pm * 256 + lane; int t[4];
#pragma unroll
                    for (int j = 0; j < 4; ++j) t[j] = sp[64 * j];
#pragma unroll
                    for (int j = 0; j < 4; ++j) IDXC[i * 256 + 64 * j + lane] = (unsigned short)(t[j] < 0 ? 0 : t[j]); }
                __syncthreads();
            }
            EpiSwiGLUI E{ws + WS_ACTM, DFE, ASCI, (const float*)nullptr, 1.f / (XSCI * WSCI)};
            pg8::gemm_phase<EpiSwiGLUI, SchedMoe, ALIGN_E, true, false, true>(L + RING_OFF, pg8::Shape{DM / 2, DM / 2, DM / 128, 0, 0, 1.f / (XSCI * WSCI)}, S, E, IDXC);
        }
        SEAM(pg);
        if (CLS(19) && IN(pg + 1)) for (int rep_ = 0; rep_ < REPC(19); ++rep_) {
            int U, full, rem, sp; moe_split(nmt, G, U, full, rem, sp);
            const float wsc = (rep_ + 1 < REPC(19)) ? 0.f : 1.f;
            {
                SchedMoe S; S.ord.init(nmt, 4, G, bx, WGM_MOEDN); S.A = (const char*)(ws + WS_ACTM); S.B = (const char*)(ws + WS_WMD); S.sa = (size_t)256 * DFE; S.sb = (size_t)256 * DFE; S.se = (size_t)1024 * DFE; S.seg = SEG;
                S.lim = (sp > 1) ? full : U;
                EpiMoeDown E{ws + WS_Y, slot_w, wsc};
                pg8::gemm_phase<EpiMoeDown, SchedMoe, ALIGN_E, false, false, true>(L + RING_OFF, pg8::Shape{DFE / 2, DFE / 2, DFE / 128, 0, 0, 1.f / (ASCI * WDSCI_M)}, S, E);
            }
            if (sp > 1) {
                SchedMoeSplit S; S.ord.init(nmt, 4, G, bx, WGM_MOEDN); S.A = (const char*)(ws + WS_ACTM); S.B = (const char*)(ws + WS_WMD); S.sa = (size_t)256 * DFE; S.sb = (size_t)256 * DFE; S.se = (size_t)1024 * DFE; S.seg = SEG;
                S.first = full; S.nparts = rem * sp; S.s = sp; S.kb = (size_t)(DFE / sp);
                EpiPart E{(bf16*)(ws + WS_PART)};
                pg8::gemm_phase<EpiPart, SchedMoeSplit, ALIGN_E, false, false, true>(L + RING_OFF, pg8::Shape{DFE / 2, DFE / 2, (DFE / 128) / sp, 0, 0, 1.f / (ASCI * WDSCI_M)}, S, E);
            }
        }
        SEAM(pg + 1);
    }
    if (CLS(19) && IN(20)) { FRESH_TID; moe_reduce((const bf16*)(ws + WS_PART), ws + WS_Y, (const int*)(ws + WS_SLOTT), (const float*)(ws + WS_SLOTW), __builtin_amdgcn_readfirstlane(SEG[NE]), G, gw, NGW, lane, 1.f); }
    SEAM(20);
    if (CLS(20) && IN(21)) { FRESH_TID;
        const bool poison = __hip_atomic_load((gu32*)(ctl + CW_BAR + XB_TMO), RLX_AGENT) != 0u;
        const GAS f32x4* gp = (const GAS f32x4*)args.in[IN_FING] + lane; f32x4 gg[4];
#pragma unroll
        for (int j = 0; j < 4; ++j) gg[j] = gp[64 * j];
        const int* toks = (const int*)(ws + WS_TOKS);
        int nsa0 = 0, nsa1 = 0, nsb0 = 0, nsb1 = 0;
        if (gw < TOK) { const int mb0 = (gw + NGW < TOK) ? gw + NGW : gw; nsa0 = toks[2 * gw]; nsa1 = toks[2 * gw + 1]; nsb0 = toks[2 * mb0]; nsb1 = toks[2 * mb0 + 1]; }
        for (int m = gw; m < TOK; m += 2 * NGW) {
            const int m2 = m + NGW; const bool has2 = m2 < TOK;
            GAS f32x4* xa = (GAS f32x4*)(X + (size_t)m * DM) + lane; GAS f32x4* xb = (GAS f32x4*)(X + (size_t)(has2 ? m2 : m) * DM) + lane; f32x4 va[4], vb[4]; float sa = 0.f, sb = 0.f;
            unsigned long long ra_[4], rb_[4];
            { const GAS unsigned long long* ga = (const GAS unsigned long long*)(XR + (size_t)m * DM) + lane; const GAS unsigned long long* gb = (const GAS unsigned long long*)(XR + (size_t)(has2 ? m2 : m) * DM) + lane;
#pragma unroll
              for (int j = 0; j < 4; ++j) ra_[j] = ga[64 * j];
#pragma unroll
              for (int j = 0; j < 4; ++j) rb_[j] = gb[64 * j]; }
#pragma unroll
            for (int j = 0; j < 4; ++j) { va[j] = (f32x4){bflo((unsigned)ra_[j]), bfhi((unsigned)ra_[j]), bflo((unsigned)(ra_[j] >> 32)), bfhi((unsigned)(ra_[j] >> 32))}; vb[j] = (f32x4){bflo((unsigned)rb_[j]), bfhi((unsigned)rb_[j]), bflo((unsigned)(rb_[j] >> 32)), bfhi((unsigned)(rb_[j] >> 32))}; }
            {
                const unsigned char* Y8 = ws + WS_Y;
                const int sa0 = __builtin_amdgcn_readfirstlane(nsa0), sa1 = __builtin_amdgcn_readfirstlane(nsa1), sb0 = __builtin_amdgcn_readfirstlane(nsb0), sb1 = __builtin_amdgcn_readfirstlane(nsb1);
                { const int mn = m + 2 * NGW; if (mn < TOK) { const int mnb = (mn + NGW < TOK) ? mn + NGW : mn; nsa0 = toks[2 * mn]; nsa1 = toks[2 * mn + 1]; nsb0 = toks[2 * mnb]; nsb1 = toks[2 * mnb + 1]; } }
                const GAS unsigned* ya0 = (const GAS unsigned*)(Y8 + (size_t)sa0 * DM) + lane; const GAS unsigned* ya1 = (const GAS unsigned*)(Y8 + (size_t)sa1 * DM) + lane;
                const GAS unsigned* yb0 = (const GAS unsigned*)(Y8 + (size_t)sb0 * DM) + lane; const GAS unsigned* yb1 = (const GAS unsigned*)(Y8 + (size_t)sb1 * DM) + lane;
                unsigned qa0[4], qa1[4], qb0[4], qb1[4];
#pragma unroll
                for (int j = 0; j < 4; ++j) { qa0[j] = ya0[64 * j]; qa1[j] = ya1[64 * j]; qb0[j] = yb0[64 * j]; qb1[j] = yb1[64 * j]; }
#define I8F(q, k) ((float)((int)((q) << (24 - 8 * (k))) >> 24))
#pragma unroll
                for (int j = 0; j < 4; ++j) { const float ys = 1.f / YSCI;
                    va[j].x += (I8F(qa0[j], 0) + I8F(qa1[j], 0)) * ys; va[j].y += (I8F(qa0[j], 1) + I8F(qa1[j], 1)) * ys; va[j].z += (I8F(qa0[j], 2) + I8F(qa1[j], 2)) * ys; va[j].w += (I8F(qa0[j], 3) + I8F(qa1[j], 3)) * ys;
                    vb[j].x += (I8F(qb0[j], 0) + I8F(qb1[j], 0)) * ys; vb[j].y += (I8F(qb0[j], 1) + I8F(qb1[j], 1)) * ys; vb[j].z += (I8F(qb0[j], 2) + I8F(qb1[j], 2)) * ys; vb[j].w += (I8F(qb0[j], 3) + I8F(qb1[j], 3)) * ys; } }
#undef I8F
#pragma unroll
            for (int j = 0; j < 4; ++j) { sa += (va[j].x * va[j].x + va[j].y * va[j].y) + (va[j].z * va[j].z + va[j].w * va[j].w); sb += (vb[j].x * vb[j].x + vb[j].y * vb[j].y) + (vb[j].z * vb[j].z + vb[j].w * vb[j].w); }
            float ra = __builtin_amdgcn_rsqf(wave_sum(sa) * (1.f / DM) + NORM_EPS), rb = __builtin_amdgcn_rsqf(wave_sum(sb) * (1.f / DM) + NORM_EPS); if (poison) { ra = __builtin_nanf(""); rb = ra; }
#pragma unroll
            for (int j = 0; j < 4; ++j) xa[64 * j] = va[j] * ra * gg[j];
            if (has2) {
#pragma unroll
                for (int j = 0; j < 4; ++j) xb[64 * j] = vb[j] * rb * gg[j]; } }
    }
#undef IN
#undef FRESH_TID
#undef CLS
#undef SEAM
}

extern "C" void kernel_launch(void* const* d_in, const int* in_sizes, int n_in, void* d_out, int out_size, void* d_ws, size_t ws_size, hipStream_t stream) {
    static int grid = 0;
    if (grid == 0) {
        if (n_in != N_IN || in_sizes[0] != TOK * DM || out_size != TOK * DM || ws_size < WS_END) { fprintf(stderr, "kernel_launch: unexpected problem shape or workspace (%d inputs, ws %zu); nothing launched\n", n_in, ws_size); grid = -1; return; }
        int dev = 0, cus = 0, per_cu = 0;
        if (hipGetDevice(&dev) != hipSuccess || hipDeviceGetAttribute(&cus, hipDeviceAttributeMultiprocessorCount, dev) != hipSuccess) { grid = -1; return; }
        if (hipFuncSetAttribute((const void*)yoco_fwd, hipFuncAttributeMaxDynamicSharedMemorySize, LDS_BYTES) != hipSuccess) { fprintf(stderr, "kernel_launch: hipFuncSetAttribute failed\n"); grid = -1; return; }
        if (hipOccupancyMaxActiveBlocksPerMultiprocessor(&per_cu, (const void*)yoco_fwd, NWAVES * 64, LDS_BYTES) != hipSuccess || per_cu < 1) { fprintf(stderr, "kernel_launch: occupancy query reports %d workgroups per CU\n", per_cu); }
        (void)hipGetLastError();
        grid = cus;
        if (grid < 128 || grid > 1024 || (MAXMT * (DFE / 128) + grid - 1) / grid > IDXC_UNITS) { fprintf(stderr, "kernel_launch: unsupported CU count %d\n", cus); grid = -1; return; }
    }
    if (grid < 0) return;
    if (hipMemsetAsync((char*)d_ws + WS_CTL, 0, CTL_ZERO_BYTES, stream) != hipSuccess) return;
    Args a{};
    for (int i = 0; i < N_IN; ++i) a.in[i] = (const float*)d_in[i];
    a.out = (float*)d_out; a.ws = (unsigned char*)d_ws; a.ph_lo = 0; a.ph_hi = N_PHASES;
    hipLaunchKernelGGL(yoco_fwd, dim3(grid), dim3(NWAVES * 64), LDS_BYTES, stream, a);
}
```
